# Optimizing an MI355X kernel written in HIP

```python
import math
import jax, jax.numpy as jnp
from jax import lax
import numpy as np

D_MODEL = 1024
BATCH = 4
SEQ = 8192
DEPTH = 1

N_META = 16
MIX_WIDTH = D_MODEL
ATTN_WIDTH = D_MODEL // 2
SSM_WIDTH = MIX_WIDTH - ATTN_WIDTH
N_HEADS = 8
V_HEAD_DIM = ATTN_WIDTH // N_HEADS
QK_NOPE_DIM = 64
QK_ROPE_DIM = 32
QK_HEAD_DIM = QK_NOPE_DIM + QK_ROPE_DIM
Q_LORA_RANK = 384
KV_LORA_RANK = 256
ROPE_BASE = 10000.0
Q_BLOCK = 128
SSM_GROUP = 16
SSM_GROUPS = SSM_WIDTH // SSM_GROUP
SSM_STATE = 64
N_DIR = 2
DT_MIN = 1e-3
DT_MAX = 1e-1
D_FF = 4 * D_MODEL
EPS = 1e-6
OFF_KV = Q_LORA_RANK
OFF_KR = OFF_KV + KV_LORA_RANK
OFF_U = OFF_KR + QK_ROPE_DIM
IN_WIDTH = OFF_U + SSM_WIDTH

kernel_name = "hymba_mla_s5_sandwich_encoder_layer"


def rms_norm(x, g):
    x32 = x.astype(jnp.float32)
    y = x32 * lax.rsqrt(jnp.mean(x32 * x32, axis=-1, keepdims=True) + EPS)
    return (y * g.astype(jnp.float32)).astype(x.dtype)


def rope_tables(pos):
    inv = 1.0 / (ROPE_BASE ** (jnp.arange(0, QK_ROPE_DIM, 2, dtype=jnp.float32) / QK_ROPE_DIM))
    ang = pos.astype(jnp.float32)[..., None] * inv
    return jnp.cos(ang), jnp.sin(ang)


def apply_rope(x, cos, sin):
    x1, x2 = jnp.split(x.astype(jnp.float32), 2, axis=-1)
    return jnp.concatenate([x1 * cos - x2 * sin, x1 * sin + x2 * cos], axis=-1).astype(x.dtype)


def mla_bidirectional(c_q, c_kv, k_r, cos, sin, g_q_lat, w_uq, g_kv_lat, w_ukv):
    bsz, L, _ = c_q.shape
    q = (rms_norm(c_q, g_q_lat) @ w_uq).reshape(bsz, L, N_HEADS, QK_HEAD_DIM)
    q_nope = q[..., :QK_NOPE_DIM]
    q_rope = apply_rope(q[..., QK_NOPE_DIM:], cos[:, :, None, :], sin[:, :, None, :])
    kv = (rms_norm(c_kv, g_kv_lat) @ w_ukv).reshape(bsz, L, N_HEADS, QK_NOPE_DIM + V_HEAD_DIM)
    k_nope = kv[..., :QK_NOPE_DIM]
    v = kv[..., QK_NOPE_DIM:]
    k_rope = apply_rope(k_r, cos, sin)
    scale = QK_HEAD_DIM ** -0.5
    n_blk = -(-L // Q_BLOCK)
    pad = n_blk * Q_BLOCK - L

    def to_blocks(t):
        t = jnp.pad(t, ((0, 0), (0, pad), (0, 0), (0, 0)))
        return t.reshape(bsz, n_blk, Q_BLOCK, N_HEADS, t.shape[-1]).transpose(1, 0, 2, 3, 4)

    def attend(blk):
        qn, qr = blk
        s = (jnp.einsum('bqhd,bkhd->bhqk', qn, k_nope, preferred_element_type=jnp.float32)
             + jnp.einsum('bqhr,bkr->bhqk', qr, k_rope, preferred_element_type=jnp.float32))
        p = jax.nn.softmax(s * scale, axis=-1)
        return jnp.einsum('bhqk,bkhd->bqhd', p.astype(v.dtype), v)

    o = lax.map(attend, (to_blocks(q_nope), to_blocks(q_rope)))
    o = o.transpose(1, 0, 2, 3, 4).reshape(bsz, n_blk * Q_BLOCK, N_HEADS * V_HEAD_DIM)
    return o[:, :L]


def _ssm_combine(left, right):
    a_l, b_l = left
    a_r, b_r = right
    return a_r * a_l, a_r * b_l + b_r


def s5_bidirectional(u, A_re, A_im, log_dt, B_re, B_im, C_re, C_im, D):
    bsz, L, _ = u.shape
    u32 = u.astype(jnp.float32).reshape(bsz, L, SSM_GROUPS, SSM_GROUP)
    uc = u32.astype(jnp.complex64)
    y = D.astype(jnp.float32).reshape(SSM_GROUPS, SSM_GROUP) * u32
    for d in range(N_DIR):
        lam = lax.complex(jnp.minimum(A_re[d].astype(jnp.float32), -1e-4), A_im[d].astype(jnp.float32))
        dt = jnp.exp(log_dt[d].astype(jnp.float32))[:, None]
        lam_bar = jnp.exp(lam * dt)
        b_c = lax.complex(B_re[d].astype(jnp.float32), B_im[d].astype(jnp.float32))
        b_bar = ((lam_bar - 1.0) / lam)[..., None] * b_c
        bu = jnp.einsum('blgh,gph->blgp', uc, b_bar)
        a = jnp.broadcast_to(lam_bar, bu.shape)
        _, xs = lax.associative_scan(_ssm_combine, (a, bu), axis=1, reverse=(d == 1))
        c_c = lax.complex(C_re[d].astype(jnp.float32), C_im[d].astype(jnp.float32))
        y = y + jnp.real(jnp.einsum('ghp,blgp->blgh', c_c, xs))
    return y.reshape(bsz, L, SSM_WIDTH)


def setup_inputs(seed: int = 0) -> dict:
    key = jax.random.key(seed)
    ks = jax.random.split(key, 32)
    nrm = lambda k, shape, s: jax.random.normal(k, shape, jnp.float32) * s
    gain = lambda k, shape: 1.0 + 0.02 * jax.random.normal(k, shape, jnp.float32)
    x = jax.random.normal(ks[0], (BATCH, SEQ, D_MODEL), jnp.float32)
    positions = jnp.broadcast_to(jnp.arange(SEQ, dtype=jnp.int32), (BATCH, SEQ))
    meta_tokens = nrm(ks[1], (N_META, D_MODEL), 1.0)
    n_idx = jnp.arange(SSM_STATE, dtype=jnp.float32)
    ssm_A_re = -0.5 + 0.01 * jax.random.normal(ks[8], (DEPTH, N_DIR, SSM_GROUPS, SSM_STATE), jnp.float32)
    ssm_A_im = jnp.broadcast_to(math.pi * n_idx, (DEPTH, N_DIR, SSM_GROUPS, SSM_STATE)) \
        + 0.01 * jax.random.normal(ks[9], (DEPTH, N_DIR, SSM_GROUPS, SSM_STATE), jnp.float32)
    ssm_log_dt = jax.random.uniform(ks[10], (DEPTH, N_DIR, SSM_GROUPS), jnp.float32,
                                    math.log(DT_MIN), math.log(DT_MAX))
    return {
        "x": x,
        "positions": positions,
        "meta_tokens": meta_tokens,
        "g_pre_mix": gain(ks[2], (DEPTH, D_MODEL)),
        "w_in": nrm(ks[3], (DEPTH, D_MODEL, IN_WIDTH), D_MODEL ** -0.5),
        "g_q_lat": gain(ks[4], (DEPTH, Q_LORA_RANK)),
        "w_uq": nrm(ks[5], (DEPTH, Q_LORA_RANK, N_HEADS * QK_HEAD_DIM), Q_LORA_RANK ** -0.5),
        "g_kv_lat": gain(ks[6], (DEPTH, KV_LORA_RANK)),
        "w_ukv": nrm(ks[7], (DEPTH, KV_LORA_RANK, N_HEADS * (QK_NOPE_DIM + V_HEAD_DIM)), KV_LORA_RANK ** -0.5),
        "ssm_A_re": ssm_A_re,
        "ssm_A_im": ssm_A_im,
        "ssm_log_dt": ssm_log_dt,
        "ssm_B_re": nrm(ks[11], (DEPTH, N_DIR, SSM_GROUPS, SSM_STATE, SSM_GROUP), (2 * SSM_GROUP) ** -0.5),
        "ssm_B_im": nrm(ks[12], (DEPTH, N_DIR, SSM_GROUPS, SSM_STATE, SSM_GROUP), (2 * SSM_GROUP) ** -0.5),
        "ssm_C_re": nrm(ks[13], (DEPTH, N_DIR, SSM_GROUPS, SSM_GROUP, SSM_STATE), SSM_STATE ** -0.5),
        "ssm_C_im": nrm(ks[14], (DEPTH, N_DIR, SSM_GROUPS, SSM_GROUP, SSM_STATE), SSM_STATE ** -0.5),
        "ssm_D": nrm(ks[15], (DEPTH, SSM_WIDTH), 1.0),
        "w_glu": nrm(ks[16], (DEPTH, SSM_WIDTH, 2 * SSM_WIDTH), SSM_WIDTH ** -0.5),
        "g_mix_out": gain(ks[17], (DEPTH, MIX_WIDTH)),
        "w_out": nrm(ks[18], (DEPTH, MIX_WIDTH, D_MODEL), MIX_WIDTH ** -0.5),
        "g_post_mix": gain(ks[19], (DEPTH, D_MODEL)),
        "g_pre_mlp": gain(ks[20], (DEPTH, D_MODEL)),
        "w_mlp_up": nrm(ks[21], (DEPTH, D_MODEL, D_FF), D_MODEL ** -0.5),
        "w_mlp_down": nrm(ks[22], (DEPTH, D_FF, D_MODEL), D_FF ** -0.5),
        "g_post_mlp": gain(ks[23], (DEPTH, D_MODEL)),
    }


def reference(x, positions, meta_tokens, g_pre_mix, w_in, g_q_lat, w_uq, g_kv_lat, w_ukv,
              ssm_A_re, ssm_A_im, ssm_log_dt, ssm_B_re, ssm_B_im, ssm_C_re, ssm_C_im, ssm_D,
              w_glu, g_mix_out, w_out, g_post_mix, g_pre_mlp, w_mlp_up, w_mlp_down, g_post_mlp):
    bsz = x.shape[0]
    meta = jnp.broadcast_to(meta_tokens.astype(x.dtype)[None], (bsz, N_META, x.shape[-1]))
    h = jnp.concatenate([meta, x], axis=1)
    meta_pos = jnp.broadcast_to(jnp.arange(N_META, dtype=jnp.int32), (bsz, N_META))
    pos = jnp.concatenate([meta_pos, positions.astype(jnp.int32) + N_META], axis=1)
    cos, sin = rope_tables(pos)
    for i in range(DEPTH):
        xn = rms_norm(h, g_pre_mix[i])
        proj = xn @ w_in[i]
        c_q = proj[..., :OFF_KV]
        c_kv = proj[..., OFF_KV:OFF_KR]
        k_r = proj[..., OFF_KR:OFF_U]
        u = proj[..., OFF_U:]
        attn = mla_bidirectional(c_q, c_kv, k_r, cos, sin, g_q_lat[i], w_uq[i], g_kv_lat[i], w_ukv[i])
        y = s5_bidirectional(u, ssm_A_re[i], ssm_A_im[i], ssm_log_dt[i], ssm_B_re[i], ssm_B_im[i],
                             ssm_C_re[i], ssm_C_im[i], ssm_D[i])
        z = jax.nn.gelu(y) @ w_glu[i].astype(jnp.float32)
        ssm = (z[..., :SSM_WIDTH] * jax.nn.sigmoid(z[..., SSM_WIDTH:])).astype(h.dtype)
        g_mix = g_mix_out[i]
        mix = jnp.concatenate([rms_norm(attn, g_mix[:ATTN_WIDTH]),
                               rms_norm(ssm, g_mix[ATTN_WIDTH:])], axis=-1)
        h = h + rms_norm(mix @ w_out[i], g_post_mix[i])
        m = rms_norm(h, g_pre_mlp[i]) @ w_mlp_up[i]
        m = jnp.square(jax.nn.relu(m)) @ w_mlp_down[i]
        h = h + rms_norm(m, g_post_mlp[i])
    return h[:, N_META:]
```

```cpp
#include <hip/hip_runtime.h>
#include <hip/hip_cooperative_groups.h>
#include <cstdio>
#include <cstdint>
namespace cg = cooperative_groups;

#define LAS __attribute__((address_space(3)))
typedef unsigned short bf16_t;
typedef short bf16x8 __attribute__((ext_vector_type(8)));
typedef short s16x4 __attribute__((ext_vector_type(4)));
typedef float f32x4 __attribute__((ext_vector_type(4)));
typedef float f32x2 __attribute__((ext_vector_type(2)));
typedef float f32x16 __attribute__((ext_vector_type(16)));
typedef unsigned u32x4 __attribute__((ext_vector_type(4)));
typedef unsigned u32x2 __attribute__((ext_vector_type(2)));

constexpr int NB = 4, SEQ = 8192, NMETA = 16, DM = 1024, DFF = 4096;
constexpr int MX = NB * SEQ;
constexpr int MT = MX + 256;
constexpr int KVR = 8256;
constexpr int NCH = 1024;
constexpr float EPS = 1e-6f;
constexpr int NWAVES = 8, NTHR = 512;
constexpr int LDS_BYTES = 147456;
constexpr float QSCALE = 0.10206207261596577f * 1.4426950408889634f;

constexpr size_t MiB = 1u << 20;
constexpr size_t WS_UM = 512 * 1024;
constexpr size_t WS_WIN = 1 * MiB, WS_WUQ = 4 * MiB, WS_WUKV = 5 * MiB, WS_WGLU = 6 * MiB, WS_WOUT = 7 * MiB, WS_WUP = 9 * MiB, WS_WDN = 17 * MiB;
constexpr size_t WS_BST = 25 * MiB, WS_MOUT = 33 * MiB, WS_KTAB = 57 * MiB, WS_TAB = 59 * MiB, WS_PART = 64 * MiB, WS_PARTA = 67 * MiB, WS_PARTS = 68 * MiB;
constexpr size_t WS_XN = 72 * MiB, WS_CQ = 137 * MiB, WS_CKV = 162 * MiB, WS_UP = 179 * MiB, WS_S = 227 * MiB, WS_Q = 259 * MiB, WS_KN = 307 * MiB, WS_VV = 340 * MiB, WS_KR = 373 * MiB;
constexpr size_t WS_MIX = 392 * MiB, WS_Y = 456 * MiB;
constexpr size_t WS_V1 = 72 * MiB, WS_XN2 = 328 * MiB, WS_H = 72 * MiB, WS_M2 = 328 * MiB, WS_END = 488 * MiB;

__device__ __forceinline__ unsigned cvt_pk_bf16(float lo, float hi) { unsigned r; asm volatile("v_cvt_pk_bf16_f32 %0, %1, %2" : "=v"(r) : "v"(lo), "v"(hi)); return r; }
__device__ __forceinline__ bf16_t f2bf(float f) { return (bf16_t)(cvt_pk_bf16(f, 0.f) & 0xffffu); }
__device__ __forceinline__ u32x4 pack8(f32x4 a, f32x4 b) { u32x4 w; w.x = cvt_pk_bf16(a[0], a[1]); w.y = cvt_pk_bf16(a[2], a[3]); w.z = cvt_pk_bf16(b[0], b[1]); w.w = cvt_pk_bf16(b[2], b[3]); return w; }
__device__ __forceinline__ float wave_sum(float v) {
#pragma unroll
    for (int o = 1; o < 64; o <<= 1) v += __shfl_xor(v, o);
    return v;
}
#define LDS_WAIT() asm volatile("s_waitcnt lgkmcnt(0)" ::: "memory")

namespace pg8 {
constexpr int BM = 256, BK = 64, HALF = 128, HTB = HALF * BK * 2, STAGE_BYTES = 8 * HTB, NXCD = 8, WGM = 8;
__device__ __forceinline__ int lds_byte(int r, int c) { const int st = (r >> 4) * 2 + (c >> 5), rr = r & 15, cc = c & 31, ob = rr * 64 + cc * 2; return st * 1024 + (ob ^ (((ob >> 9) & 1) << 5)); }
__device__ __forceinline__ void stage_rc(int b, int& R, int& C) { const int st = b / 1024, sb = b % 1024, swz = sb ^ (((sb >> 9) & 1) << 5); R = (st >> 1) * 16 + swz / 64; C = (st & 1) * 32 + (swz % 64) / 2; }
__device__ __forceinline__ int perm32(int rho) { const int n = rho >> 4, i = rho & 15; return 8 * (i >> 2) + 4 * n + (i & 3); }

struct Unit { int pm, pn, pg; };
struct Gemm { const bf16_t* A; const bf16_t* Bt; int lda, ldb, K; size_t gsA, gsB; };

struct Order {
    int nM, nN, per, nwg, G, c;
    __device__ void init(int nM_, int nN_, int nG_, int G_, int c_) { nM = nM_; nN = nN_; per = nM_ * nN_; nwg = per * nG_; G = G_; c = c_; }
    __device__ bool next(int i, Unit& u) const {
        const long L = (long)i * G + c; if (L >= nwg) return false;
        int wgid = (int)L; { const int q = nwg / NXCD, r = nwg % NXCD, xcd = wgid % NXCD, off = wgid / NXCD; wgid = (xcd < r ? xcd * (q + 1) : r * (q + 1) + (xcd - r) * q) + off; }
        const int pg = wgid / per, w = wgid % per;
        const int nig = WGM * nN, gid = w / nig, fm = gid * WGM, gsz = (nM - fm) < WGM ? (nM - fm) : WGM;
        u.pm = fm + ((w % nig) % gsz); u.pn = (w % nig) / gsz; u.pg = pg; return true;
    }
};

template <class Epi, bool ALIGN_EPI>
__device__ __forceinline__ void gemm_phase(LAS unsigned char* lds, const Gemm g, const Order& S, const Epi& E) {
    int tid = threadIdx.x; asm volatile("" : "+v"(tid));
    const int wid = __builtin_amdgcn_readfirstlane(tid >> 6), lane = tid & 63, wr = wid >> 2, wc = wid & 3; int fr = lane & 15, fq = lane >> 4;
    const int K = g.K, nt = K / BK;
    unsigned voffA[2], voffB[2];
#pragma unroll
    for (int i = 0; i < 2; ++i) { int R, C; stage_rc(tid * 16 + i * 8192, R, C); const int Rb = Epi::PERM ? ((R & ~31) + perm32(R & 31)) : R;
        voffA[i] = (unsigned)(R * g.lda + C) * 2u; voffB[i] = (unsigned)(Rb * g.ldb + C) * 2u; }
    const size_t kstep = (size_t)(BK * 2);
    const size_t hstepA = (size_t)HALF * g.lda * 2, hstepB = (size_t)HALF * g.ldb * 2;
    const size_t tstepA = 2 * hstepA, tstepB = 2 * hstepB;
    const unsigned ldsw = (unsigned)wid * 1024u;
    const int aoff = lds_byte(wr * 64 + fr, fq * 8), boff = lds_byte(wc * 32 + fr, fq * 8);
#define PG8_SA(b, h) (((b) * 2 + (h)) * HTB)
#define PG8_SB(b, h) ((4 + (b) * 2 + (h)) * HTB)
#define PG8_STAGE(bufoff, gbase, voff) do { _Pragma("unroll") for (int _i = 0; _i < 2; ++_i) \
        __builtin_amdgcn_global_load_lds((const unsigned*)((const char*)(gbase) + (voff)[_i]), (LAS unsigned*)(lds + (bufoff) + ldsw + _i * 8192), 16, 0, 0); } while (0)
#define PG8_LDA(dst, b, h) do { _Pragma("unroll") for (int m = 0; m < 4; ++m) _Pragma("unroll") for (int k = 0; k < 2; ++k) dst[m][k] = *(const LAS bf16x8*)(lds + PG8_SA(b, h) + aoff + m * 2048 + k * 1024); } while (0)
#define PG8_LDB(dst, b, h) do { _Pragma("unroll") for (int n = 0; n < 2; ++n) _Pragma("unroll") for (int k = 0; k < 2; ++k) dst[n][k] = *(const LAS bf16x8*)(lds + PG8_SB(b, h) + boff + n * 2048 + k * 1024); } while (0)
#define PG8_MMA(ai, bj, At, Bt) do { __builtin_amdgcn_s_setprio(1); _Pragma("unroll") for (int m = 0; m < 4; ++m) _Pragma("unroll") for (int n = 0; n < 2; ++n) _Pragma("unroll") for (int k = 0; k < 2; ++k) \
        acc[ai][bj][m][n] = __builtin_amdgcn_mfma_f32_16x16x32_bf16(Bt[n][k], At[m][k], acc[ai][bj][m][n], 0, 0, 0); __builtin_amdgcn_s_setprio(0); } while (0)
#define PG8_WAIT_V(n) asm volatile("s_waitcnt vmcnt(" #n ")" ::: "memory")
#define PG8_WAIT_L(n) asm volatile("s_waitcnt lgkmcnt(" #n ")" ::: "memory")
#define PG8_BAR __builtin_amdgcn_s_barrier()
#define PG8_SCHED __builtin_amdgcn_sched_barrier(0)
    Unit cur, nxt; int ui = 0;
    if (!S.next(0, cur)) return;
    f32x4 acc[2][2][4][2];
#pragma unroll
    for (int a = 0; a < 2; ++a)
#pragma unroll
        for (int b = 0; b < 2; ++b)
#pragma unroll
            for (int m = 0; m < 4; ++m)
#pragma unroll
                for (int n = 0; n < 2; ++n) acc[a][b][m][n] = (f32x4){0.f, 0.f, 0.f, 0.f};
    bf16x8 At[4][2], B0[2][2], B1[2][2];
    const char* cA = (const char*)g.A + ((size_t)cur.pg * g.gsA) * 2 + (size_t)cur.pm * tstepA; const char* cB = (const char*)g.Bt + ((size_t)cur.pg * g.gsB) * 2 + (size_t)cur.pn * tstepB;
    PG8_STAGE(PG8_SB(0, 0), cB, voffB); PG8_STAGE(PG8_SB(0, 1), cB + hstepB, voffB); PG8_STAGE(PG8_SA(0, 0), cA, voffA); PG8_STAGE(PG8_SA(0, 1), cA + hstepA, voffA);
    if (wr == 1) PG8_BAR;
    PG8_WAIT_V(2); PG8_BAR;
    PG8_STAGE(PG8_SB(1, 0), cB + kstep, voffB); PG8_STAGE(PG8_SA(1, 0), cA + kstep, voffA); PG8_STAGE(PG8_SB(1, 1), cB + hstepB + kstep, voffB);
    PG8_WAIT_V(6); PG8_BAR;
    for (;;) {
        const bool has_next = S.next(ui + 1, nxt);
        const char* nA = has_next ? (const char*)g.A + ((size_t)nxt.pg * g.gsA) * 2 + (size_t)nxt.pm * tstepA : cA;
        const char* nB = has_next ? (const char*)g.Bt + ((size_t)nxt.pg * g.gsB) * 2 + (size_t)nxt.pn * tstepB : cB;
#pragma unroll 1
        for (int t = 0; t < nt; t += 2) {
            if constexpr (Epi::MID) { if (t == (nt >> 1)) E.mid(acc, cur, wr, wc, fr, fq); }
            const bool last = (t == nt - 2);
            const char* a1 = cA + (size_t)(t + 1) * kstep;
            const char* a2 = last ? nA : cA + (size_t)(t + 2) * kstep; const char* b2 = last ? nB : cB + (size_t)(t + 2) * kstep;
            const char* a3 = a2 + kstep; const char* b3 = b2 + kstep;
            PG8_LDB(B0, 0, 0); PG8_LDB(B1, 0, 1); PG8_SCHED; PG8_LDA(At, 0, 0); PG8_STAGE(PG8_SA(1, 1), a1 + hstepA, voffA);
            PG8_WAIT_V(8); PG8_WAIT_L(0); PG8_BAR; PG8_MMA(0, 0, At, B0); PG8_MMA(0, 1, At, B1); PG8_BAR; PG8_SCHED;
            PG8_LDA(At, 0, 1); PG8_STAGE(PG8_SB(0, 0), b2, voffB); PG8_STAGE(PG8_SB(0, 1), b2 + hstepB, voffB); PG8_STAGE(PG8_SA(0, 0), a2, voffA);
            PG8_WAIT_V(8); PG8_WAIT_L(0); PG8_BAR; PG8_MMA(1, 0, At, B0); PG8_MMA(1, 1, At, B1); PG8_BAR; PG8_SCHED;
            PG8_LDB(B0, 1, 0); PG8_LDB(B1, 1, 1); PG8_SCHED; PG8_LDA(At, 1, 0); PG8_STAGE(PG8_SA(0, 1), a2 + hstepA, voffA);
            PG8_WAIT_V(8); PG8_WAIT_L(0); PG8_BAR; PG8_MMA(0, 0, At, B0); PG8_MMA(0, 1, At, B1); PG8_BAR; PG8_SCHED;
            PG8_LDA(At, 1, 1); PG8_STAGE(PG8_SB(1, 0), b3, voffB); PG8_STAGE(PG8_SB(1, 1), b3 + hstepB, voffB); PG8_STAGE(PG8_SA(1, 0), a3, voffA);
            PG8_WAIT_V(8); PG8_WAIT_L(0); PG8_BAR; PG8_MMA(1, 0, At, B0); PG8_MMA(1, 1, At, B1); PG8_BAR; PG8_SCHED;
        }
        if constexpr (ALIGN_EPI) { if (wr == 0) PG8_BAR; }
        E(acc, cur, wr, wc, fr, fq);
        if (!has_next) break;
#pragma unroll
        for (int a = 0; a < 2; ++a)
#pragma unroll
            for (int b = 0; b < 2; ++b)
#pragma unroll
                for (int m = 0; m < 4; ++m)
#pragma unroll
                    for (int n = 0; n < 2; ++n) acc[a][b][m][n] = (f32x4){0.f, 0.f, 0.f, 0.f};
        cur = nxt; cA = nA; cB = nB; ++ui;
        if constexpr (ALIGN_EPI) { if (wr == 1) PG8_BAR; }
    }
    PG8_WAIT_V(0);
    if constexpr (!ALIGN_EPI) { if (wr == 0) PG8_BAR; }
    PG8_BAR;
#undef PG8_SA
#undef PG8_SB
#undef PG8_STAGE
#undef PG8_LDA
#undef PG8_LDB
#undef PG8_MMA
#undef PG8_WAIT_V
#undef PG8_WAIT_L
#undef PG8_BAR
#undef PG8_SCHED
}
}
using pg8::Unit;
typedef f32x4 Acc[2][2][4][2];

__device__ __forceinline__ int kvrow_of(int row) { return (row >> 13) * KVR + (row & 8191); }

struct EpiProj {
    static constexpr bool PERM = true, MID = false;
    bf16_t *CQ, *CKV, *UP, *KR; float *PART, *UM; const float* TAB;
    __device__ __forceinline__ void operator()(const Acc& acc, const Unit& u, int wr, int wc, int fr, int fq) const {
        asm volatile("" : "+v"(fr), "+v"(fq));
#pragma unroll
        for (int bj = 0; bj < 2; ++bj) {
            const int gidx = u.pn * 8 + bj * 4 + wc;
            if (gidx >= 37) continue;
#pragma unroll
            for (int ai = 0; ai < 2; ++ai)
#pragma unroll
                for (int m = 0; m < 4; ++m) {
                    const int row = u.pm * 256 + ai * 128 + wr * 64 + m * 16 + fr;
                    const bool meta = row >= MX; const int j = row - MX; const bool ok = !meta || j < NMETA;
                    const f32x4 v0 = acc[ai][bj][m][0], v1 = acc[ai][bj][m][1];
                    if (gidx < 20) {
                        float ss = (v0[0] * v0[0] + v0[1] * v0[1]) + (v0[2] * v0[2] + v0[3] * v0[3]) + (v1[0] * v1[0] + v1[1] * v1[1]) + (v1[2] * v1[2] + v1[3] * v1[3]);
                        ss += __shfl_xor(ss, 16); ss += __shfl_xor(ss, 32);
                        if (ok) {
                            bf16_t* dst = gidx < 12 ? CQ + (size_t)row * 384 + gidx * 32 + 8 * fq : CKV + (size_t)row * 256 + (gidx - 12) * 32 + 8 * fq;
                            *(u32x4*)dst = pack8(v0, v1);
                            if (fq == 0) PART[(size_t)row * 20 + gidx] = ss;
                        }
                    } else if (gidx < 36) {
                        const int ch0 = (gidx - 20) * 32 + 8 * fq;
                        if (!meta) { const int g = ch0 >> 4, h0 = ch0 & 15, n = row >> 5, i = row & 31;
                            *(u32x4*)(UP + ((size_t)(g * NCH + n) * 768 + i * 16 + h0)) = pack8(v0, v1);
                        } else if (ok) { float* d = UM + j * 512 + ch0; *(f32x4*)d = v0; *(f32x4*)(d + 4) = v1; }
                    } else {
                        if (ok) {
                            const f32x4 cs = *(const f32x4*)(TAB + (size_t)row * 32 + 4 * fq), sn = *(const f32x4*)(TAB + (size_t)row * 32 + 16 + 4 * fq);
                            f32x4 o0, o1;
                            o0[0] = v0[0] * cs[0] - v0[1] * sn[0]; o0[1] = v0[0] * sn[0] + v0[1] * cs[0];
                            o0[2] = v0[2] * cs[1] - v0[3] * sn[1]; o0[3] = v0[2] * sn[1] + v0[3] * cs[1];
                            o1[0] = v1[0] * cs[2] - v1[1] * sn[2]; o1[1] = v1[0] * sn[2] + v1[1] * cs[2];
                            o1[2] = v1[2] * cs[3] - v1[3] * sn[3]; o1[3] = v1[2] * sn[3] + v1[3] * cs[3];
                            const u32x4 w = pack8(o0, o1);
                            if (!meta) *(u32x4*)(KR + (size_t)kvrow_of(row) * 32 + 8 * fq) = w;
                            else {
#pragma unroll
                                for (int b = 0; b < NB; ++b) *(u32x4*)(KR + (size_t)(b * KVR + SEQ + j) * 32 + 8 * fq) = w; }
                        }
                    }
                }
        }
    }
};
__device__ __forceinline__ float rstd_from(const float* p, int cnt4, float inv_n) {
    float s = 0.f;
    for (int i = 0; i < cnt4; ++i) { const f32x4 v = *(const f32x4*)(p + 4 * i); s += (v[0] + v[1]) + (v[2] + v[3]); }
    return __builtin_amdgcn_rsqf(s * inv_n + EPS);
}
struct EpiQ {
    static constexpr bool PERM = true, MID = false;
    bf16_t* Q; const float* PART; const float* TAB;
    __device__ __forceinline__ void operator()(const Acc& acc, const Unit& u, int wr, int wc, int fr, int fq) const {
        asm volatile("" : "+v"(fr), "+v"(fq));
#pragma unroll
        for (int ai = 0; ai < 2; ++ai)
#pragma unroll
            for (int m = 0; m < 4; ++m) {
                const int row = u.pm * 256 + ai * 128 + wr * 64 + m * 16 + fr;
                const float sc = rstd_from(PART + (size_t)row * 20, 3, 1.0f / 384.0f) * QSCALE;
#pragma unroll
                for (int bj = 0; bj < 2; ++bj) {
                    const int gidx = u.pn * 8 + bj * 4 + wc;
                    f32x4 v0 = acc[ai][bj][m][0] * sc, v1 = acc[ai][bj][m][1] * sc;
                    if (gidx % 3 == 2) {
                        const f32x4 cs = *(const f32x4*)(TAB + (size_t)row * 32 + 4 * fq), sn = *(const f32x4*)(TAB + (size_t)row * 32 + 16 + 4 * fq);
                        f32x4 o0, o1;
                        o0[0] = v0[0] * cs[0] - v0[1] * sn[0]; o0[1] = v0[0] * sn[0] + v0[1] * cs[0];
                        o0[2] = v0[2] * cs[1] - v0[3] * sn[1]; o0[3] = v0[2] * sn[1] + v0[3] * cs[1];
                        o1[0] = v1[0] * cs[2] - v1[1] * sn[2]; o1[1] = v1[0] * sn[2] + v1[1] * cs[2];
                        o1[2] = v1[2] * cs[3] - v1[3] * sn[3]; o1[3] = v1[2] * sn[3] + v1[3] * cs[3];
                        v0 = o0; v1 = o1;
                    }
                    *(u32x4*)(Q + (size_t)row * 768 + gidx * 32 + 8 * fq) = pack8(v0, v1);
                }
                asm volatile("" ::: "memory");
            }
    }
};
struct EpiKV {
    static constexpr bool PERM = true, MID = false;
    bf16_t *KN, *VV; const float* PART;
    __device__ __forceinline__ void operator()(const Acc& acc, const Unit& u, int wr, int wc, int fr, int fq) const {
        asm volatile("" : "+v"(fr), "+v"(fq));
#pragma unroll
        for (int ai = 0; ai < 2; ++ai)
#pragma unroll
            for (int m = 0; m < 4; ++m) {
                const int row = u.pm * 256 + ai * 128 + wr * 64 + m * 16 + fr;
                const bool meta = row >= MX; const int j = row - MX; if (meta && j >= NMETA) continue;
                const float sc = rstd_from(PART + (size_t)row * 20 + 12, 2, 1.0f / 256.0f);
#pragma unroll
                for (int bj = 0; bj < 2; ++bj) {
                    const int gidx = u.pn * 8 + bj * 4 + wc;
                    const u32x4 w = pack8(acc[ai][bj][m][0] * sc, acc[ai][bj][m][1] * sc);
                    bf16_t* base = gidx < 16 ? KN : VV; const int col = (gidx & 15) * 32 + 8 * fq;
                    if (!meta) *(u32x4*)(base + (size_t)kvrow_of(row) * 512 + col) = w;
                    else {
#pragma unroll
                        for (int b = 0; b < NB; ++b) *(u32x4*)(base + (size_t)(b * KVR + SEQ + j) * 512 + col) = w; }
                }
                asm volatile("" ::: "memory");
            }
    }
};
struct EpiState {
    static constexpr bool PERM = false, MID = false;
    float* S;
    __device__ __forceinline__ void operator()(const Acc& acc, const Unit& u, int wr, int wc, int fr, int fq) const {
        asm volatile("" : "+v"(fr), "+v"(fq));
#pragma unroll
        for (int ai = 0; ai < 2; ++ai)
#pragma unroll
            for (int m = 0; m < 4; ++m) {
                const int row = u.pm * 256 + ai * 128 + wr * 64 + m * 16 + fr;
                float* d = S + ((size_t)u.pg * NCH + row) * 256 + wc * 32 + 4 * fq;
#pragma unroll
                for (int bj = 0; bj < 2; ++bj)
#pragma unroll
                    for (int n = 0; n < 2; ++n) *(f32x4*)(d + bj * 128 + n * 16) = acc[ai][bj][m][n];
            }
    }
};
__device__ __forceinline__ float gelu_tanh(float v) {
    const float t = v * (1.0f + 0.044715f * v * v) * (-2.0f * 0.7978845608028654f * 1.4426950408889634f);
    return v * __builtin_amdgcn_rcpf(1.0f + __builtin_amdgcn_exp2f(t));
}
struct EpiY {
    static constexpr bool PERM = true, MID = false;
    bf16_t* Y;
    __device__ __forceinline__ void operator()(const Acc& acc, const Unit& u, int wr, int wc, int fr, int fq) const {
        asm volatile("" : "+v"(fr), "+v"(fq));
#pragma unroll
        for (int ai = 0; ai < 2; ++ai)
#pragma unroll
            for (int m = 0; m < 4; ++m) {
                const int n = u.pm * 256 + ai * 128 + wr * 64 + m * 16 + fr;
#pragma unroll
                for (int bj = 0; bj < 2; ++bj) {
                    const int c = u.pn * 256 + bj * 128 + wc * 32 + 8 * fq, i = c >> 4, h0 = c & 15;
                    f32x4 v0 = acc[ai][bj][m][0], v1 = acc[ai][bj][m][1];
#pragma unroll
                    for (int e = 0; e < 4; ++e) { v0[e] = gelu_tanh(v0[e]); v1[e] = gelu_tanh(v1[e]); }
                    *(u32x4*)(Y + (size_t)(n * 32 + i) * 512 + u.pg * 16 + h0) = pack8(v0, v1);
                }
            }
    }
};
struct EpiGLU {
    static constexpr bool PERM = true, MID = false;
    bf16_t* MIX; float* PARTS;
    __device__ __forceinline__ void operator()(const Acc& acc, const Unit& u, int wr, int wc, int fr, int fq) const {
        asm volatile("" : "+v"(fr), "+v"(fq));
#pragma unroll
        for (int ai = 0; ai < 2; ++ai)
#pragma unroll
            for (int m = 0; m < 4; ++m) {
                const int row = u.pm * 256 + ai * 128 + wr * 64 + m * 16 + fr;
#pragma unroll
                for (int bj = 0; bj < 2; ++bj) {
                    const f32x4 z1 = acc[ai][bj][m][0], z2 = acc[ai][bj][m][1]; f32x4 o;
#pragma unroll
                    for (int e = 0; e < 4; ++e) o[e] = z1[e] * __builtin_amdgcn_rcpf(1.0f + __builtin_amdgcn_exp2f(-1.4426950408889634f * z2[e]));
                    float ss = (o[0] * o[0] + o[1] * o[1]) + (o[2] * o[2] + o[3] * o[3]);
                    ss += __shfl_xor(ss, 16); ss += __shfl_xor(ss, 32);
                    const int sc = u.pn * 128 + bj * 64 + wc * 16 + 4 * fq;
                    u32x2 w; w.x = cvt_pk_bf16(o[0], o[1]); w.y = cvt_pk_bf16(o[2], o[3]);
                    *(u32x2*)(MIX + (size_t)row * 1024 + 512 + sc) = w;
                    if (fq == 0) PARTS[(size_t)row * 32 + u.pn * 8 + bj * 4 + wc] = ss;
                }
            }
    }
};
struct EpiWout {
    static constexpr bool PERM = false, MID = true;
    float* V1; const float *PARTA, *PARTS;
    __device__ __forceinline__ void mid(Acc& acc, const Unit& u, int wr, int wc, int fr, int fq) const {
        asm volatile("" : "+v"(fr), "+v"(fq));
#pragma unroll
        for (int ai = 0; ai < 2; ++ai)
#pragma unroll
            for (int m = 0; m < 4; ++m) {
                const int row = u.pm * 256 + ai * 128 + wr * 64 + m * 16 + fr;
                const float ra = rstd_from(PARTA + (size_t)row * 8, 2, 1.0f / 512.0f), rs = rstd_from(PARTS + (size_t)row * 32, 8, 1.0f / 512.0f);
                const float f = ra / rs;
#pragma unroll
                for (int bj = 0; bj < 2; ++bj)
#pragma unroll
                    for (int n = 0; n < 2; ++n) acc[ai][bj][m][n] *= f;
                asm volatile("" ::: "memory");
            }
    }
    __device__ __forceinline__ void operator()(const Acc& acc, const Unit& u, int wr, int wc, int fr, int fq) const {
        asm volatile("" : "+v"(fr), "+v"(fq));
#pragma unroll
        for (int ai = 0; ai < 2; ++ai)
#pragma unroll
            for (int m = 0; m < 4; ++m) {
                const int row = u.pm * 256 + ai * 128 + wr * 64 + m * 16 + fr;
                const float rs = rstd_from(PARTS + (size_t)row * 32, 8, 1.0f / 512.0f);
                float* d = V1 + (size_t)row * 1024 + u.pn * 256 + wc * 32 + 4 * fq;
#pragma unroll
                for (int bj = 0; bj < 2; ++bj)
#pragma unroll
                    for (int n = 0; n < 2; ++n) *(f32x4*)(d + bj * 128 + n * 16) = acc[ai][bj][m][n] * rs;
                asm volatile("" ::: "memory");
            }
    }
};
struct EpiRelu2 {
    static constexpr bool PERM = true, MID = false;
    bf16_t* H;
    __device__ __forceinline__ void operator()(const Acc& acc, const Unit& u, int wr, int wc, int fr, int fq) const {
        asm volatile("" : "+v"(fr), "+v"(fq));
#pragma unroll
        for (int ai = 0; ai < 2; ++ai)
#pragma unroll
            for (int m = 0; m < 4; ++m) {
                const int row = u.pm * 256 + ai * 128 + wr * 64 + m * 16 + fr;
#pragma unroll
                for (int bj = 0; bj < 2; ++bj) {
                    f32x4 v0 = acc[ai][bj][m][0], v1 = acc[ai][bj][m][1];
#pragma unroll
                    for (int e = 0; e < 4; ++e) { const float a = fmaxf(v0[e], 0.f), b = fmaxf(v1[e], 0.f); v0[e] = a * a; v1[e] = b * b; }
                    *(u32x4*)(H + (size_t)row * DFF + u.pn * 256 + bj * 128 + wc * 32 + 8 * fq) = pack8(v0, v1);
                }
            }
    }
};
struct EpiF32 {
    static constexpr bool PERM = false, MID = false;
    float* O;
    __device__ __forceinline__ void operator()(const Acc& acc, const Unit& u, int wr, int wc, int fr, int fq) const {
        asm volatile("" : "+v"(fr), "+v"(fq));
#pragma unroll
        for (int ai = 0; ai < 2; ++ai)
#pragma unroll
            for (int m = 0; m < 4; ++m) {
                const int row = u.pm * 256 + ai * 128 + wr * 64 + m * 16 + fr;
                float* d = O + (size_t)row * 1024 + u.pn * 256 + wc * 32 + 4 * fq;
#pragma unroll
                for (int bj = 0; bj < 2; ++bj)
#pragma unroll
                    for (int n = 0; n < 2; ++n) *(f32x4*)(d + bj * 128 + n * 16) = acc[ai][bj][m][n];
            }
    }
};

namespace attn {
constexpr int NW = 8, QBLK = 32, KVBLK = 64, NT = KVR / KVBLK;
constexpr int SHM_K = KVBLK * 96 * 2, SHM_V = KVBLK * 64 * 2;
constexpr int OFF_V = 0, OFF_K = 2 * SHM_V, OFF_WS = OFF_K + 2 * SHM_K, OFF_OST = OFF_WS + NW * 64 * 4, OST_WAVE = 32 * 272, LDS_END = OFF_OST + NW * OST_WAVE;
constexpr float THR = 11.5f;
#define SBAR() __builtin_amdgcn_sched_barrier(0)
__device__ __forceinline__ int crow(int r, int hi) { return (r & 3) + 8 * (r >> 2) + 4 * hi; }
__device__ __forceinline__ void partialSM(f32x16& p0, f32x16& p1, float& m_reg, float& alpha) {
    float pmax = p0[0];
#pragma unroll
    for (int r = 1; r < 16; ++r) pmax = fmaxf(pmax, p0[r]);
#pragma unroll
    for (int r = 0; r < 16; ++r) pmax = fmaxf(pmax, p1[r]);
    { auto rr = __builtin_amdgcn_permlane32_swap(__float_as_uint(pmax), __float_as_uint(pmax), false, false);
      pmax = fmaxf(__uint_as_float(rr[0]), __uint_as_float(rr[1])); }
    float mn;
    if (__builtin_expect(__all(pmax - m_reg <= THR), 1)) { mn = m_reg; alpha = 1.f; }
    else { mn = fmaxf(m_reg, pmax); alpha = __builtin_amdgcn_exp2f(m_reg - mn); m_reg = mn; }
#pragma unroll
    for (int r = 0; r < 16; ++r) p0[r] = p0[r] - mn;
#pragma unroll
    for (int r = 0; r < 16; ++r) p1[r] = p1[r] - mn;
#pragma unroll
    for (int r = 0; r < 16; ++r) p0[r] = __builtin_amdgcn_exp2f(p0[r]);
}
__device__ __forceinline__ void finishSM(f32x16& p0, f32x16& p1, float alpha, float& l_reg, bf16x8& pa0, bf16x8& pa1, bf16x8& pa2, bf16x8& pa3) {
#pragma unroll
    for (int r = 0; r < 16; ++r) p1[r] = __builtin_amdgcn_exp2f(p1[r]);
    float ps = 0;
#pragma unroll
    for (int r = 0; r < 16; ++r) ps += p0[r];
#pragma unroll
    for (int r = 0; r < 16; ++r) ps += p1[r];
    { auto rr = __builtin_amdgcn_permlane32_swap(__float_as_uint(ps), __float_as_uint(ps), false, false);
      ps = __uint_as_float(rr[0]) + __uint_as_float(rr[1]); }
    l_reg = l_reg * alpha + ps;
#define PK4(P, BASE, OUT) do { unsigned a0 = cvt_pk_bf16(P[BASE + 0], P[BASE + 1]), a1 = cvt_pk_bf16(P[BASE + 2], P[BASE + 3]);   \
    unsigned b0 = cvt_pk_bf16(P[BASE + 4], P[BASE + 5]), b1 = cvt_pk_bf16(P[BASE + 6], P[BASE + 7]);                              \
    auto r0 = __builtin_amdgcn_permlane32_swap(a0, b0, false, false); auto r1 = __builtin_amdgcn_permlane32_swap(a1, b1, false, false); \
    u32x4 w = {r0[0], r1[0], r0[1], r1[1]}; OUT = *reinterpret_cast<bf16x8*>(&w); } while (0)
    PK4(p0, 0, pa0); PK4(p0, 8, pa1); PK4(p1, 0, pa2); PK4(p1, 8, pa3);
#undef PK4
}
__device__ __forceinline__ void qkt(f32x16& p0, f32x16& p1, const char* Ks, const bf16x8* qr, int kbase) {
    p0 = f32x16{}; p1 = f32x16{};
#pragma unroll
    for (int d0 = 0; d0 < 6; ++d0) {
        const char* a = Ks + d0 * 2048 + (kbase ^ (((2 * d0) & 7) << 4));
        const bf16x8 b0 = *reinterpret_cast<const bf16x8*>(a), b1 = *reinterpret_cast<const bf16x8*>(a + 512);
        p0 = __builtin_amdgcn_mfma_f32_32x32x16_bf16(b0, qr[d0], p0, 0, 0, 0);
        p1 = __builtin_amdgcn_mfma_f32_32x32x16_bf16(b1, qr[d0], p1, 0, 0, 0);
    }
}
__device__ __forceinline__ int v_st(int k, int c) { const int kk = (k & ~0xC) | ((k & 4) << 1) | ((k & 8) >> 1); return ((kk >> 3) * 2 + (c >> 5)) * 512 + ((kk & 7) * 32 + (c & 31)) * 2; }
__device__ __forceinline__ int v_rd_base(int lane) { return ((lane & 3) << 3) | (((lane >> 2) & 3) << 6) | (((lane >> 4) & 1) << 5) | (((lane >> 5) & 1) << 8); }
constexpr int v_rd_off(int d0, int ks, int half) { return d0 * 512 + ks * 2048 + half * 1024; }
template <int OFF> __device__ __forceinline__ s16x4 tr_read(int vb) {
    s16x4 r; asm volatile("ds_read_b64_tr_b16 %0, %1 offset:%2" : "=&v"(r) : "v"(vb), "i"(OFF) : "memory"); return r;
}
template <int D0> __device__ __forceinline__ void pv_one(f32x16& od, int vb, bf16x8 pa0, bf16x8 pa1, bf16x8 pa2, bf16x8 pa3) {
    const s16x4 l0 = tr_read<v_rd_off(D0, 0, 0)>(vb), h0 = tr_read<v_rd_off(D0, 0, 1)>(vb), l1 = tr_read<v_rd_off(D0, 1, 0)>(vb), h1 = tr_read<v_rd_off(D0, 1, 1)>(vb);
    const s16x4 l2 = tr_read<v_rd_off(D0, 2, 0)>(vb), h2 = tr_read<v_rd_off(D0, 2, 1)>(vb), l3 = tr_read<v_rd_off(D0, 3, 0)>(vb), h3 = tr_read<v_rd_off(D0, 3, 1)>(vb);
    asm volatile("s_waitcnt lgkmcnt(0)" ::: "memory"); SBAR();
#define PK(L, H) (bf16x8){L[0], L[1], L[2], L[3], H[0], H[1], H[2], H[3]}
    od = __builtin_amdgcn_mfma_f32_32x32x16_bf16(pa0, PK(l0, h0), od, 0, 0, 0);
    od = __builtin_amdgcn_mfma_f32_32x32x16_bf16(pa1, PK(l1, h1), od, 0, 0, 0);
    od = __builtin_amdgcn_mfma_f32_32x32x16_bf16(pa2, PK(l2, h2), od, 0, 0, 0);
    od = __builtin_amdgcn_mfma_f32_32x32x16_bf16(pa3, PK(l3, h3), od, 0, 0, 0);
#undef PK
}
__device__ __forceinline__ void pv_d0(f32x16* o, int vb, bf16x8 pa0, bf16x8 pa1, bf16x8 pa2, bf16x8 pa3) {
    pv_one<0>(o[0], vb, pa0, pa1, pa2, pa3); pv_one<1>(o[1], vb, pa0, pa1, pa2, pa3);
}
__device__ __forceinline__ void attn_unit(int b, int h, int qb, const bf16_t* __restrict__ Q, const bf16_t* __restrict__ KN, const bf16_t* __restrict__ KRp, const bf16_t* __restrict__ VV,
                                          bf16_t* MIX, float* PARTA, char* lds) {
    int tid = threadIdx.x; asm volatile("" : "+v"(tid));
    const int wid = __builtin_amdgcn_readfirstlane(tid >> 6), lane = tid & 63, r32 = lane & 31, hi = lane >> 5;
    char* V_lds = lds + OFF_V; char* K_lds = lds + OFF_K;
    float* ws = (float*)(lds + OFF_WS) + wid * 64; float* li_l = ws; float* al_l = ws + 32;
    float m_reg = -1e30f, l_reg = 0; f32x16 o[2] = {}; bf16x8 qr[6];
    const int xr0 = b * SEQ + qb * 256 + wid * QBLK;
    const bf16_t* Qw = Q + (size_t)(xr0 + r32) * 768 + h * 96 + hi * 8;
#pragma unroll
    for (int d0 = 0; d0 < 6; ++d0) qr[d0] = *reinterpret_cast<const bf16x8*>(Qw + d0 * 16);
    const int srow = tid >> 3, sc8 = tid & 7;
    const int rrow = (tid >> 2) & 63, rc = tid & 3;
    const bool do_rope = wid < 4;
    const size_t kvb = (size_t)b * KVR;
    const bf16_t* kn_src = KN + (kvb + srow) * 512 + h * 64 + sc8 * 8;
    const bf16_t* vv_src = VV + (kvb + srow) * 512 + h * 64 + sc8 * 8;
    const bf16_t* kr_src = KRp + (kvb + rrow) * 32 + rc * 8;
    const int kn_dst = sc8 * 1024 + ((srow ^ sc8) << 4), kr_dst = (8 + rc) * 1024 + ((rrow ^ rc) << 4), vv_dst = v_st(srow, sc8 * 8);
    const int kbase = hi * 1024 + ((r32 ^ hi) << 4);
    const int vb0 = (int)(uintptr_t)V_lds + v_rd_base(lane);
    struct { bf16x8 kn, kr, vv; } sr_[2];
#define SLOAD(i, t) do { sr_[i].kn = *reinterpret_cast<const bf16x8*>(kn_src + (size_t)(t) * KVBLK * 512); sr_[i].vv = *reinterpret_cast<const bf16x8*>(vv_src + (size_t)(t) * KVBLK * 512); \
    if (do_rope) sr_[i].kr = *reinterpret_cast<const bf16x8*>(kr_src + (size_t)(t) * KVBLK * 32); } while (0)
#define SWRITE(bb, i) do { *(bf16x8*)(V_lds + (bb) * SHM_V + vv_dst) = sr_[i].vv; *(bf16x8*)(K_lds + (bb) * SHM_K + kn_dst) = sr_[i].kn; \
    if (do_rope) *(bf16x8*)(K_lds + (bb) * SHM_K + kr_dst) = sr_[i].kr; } while (0)
#define RESC(a) do { if (__any((a) < 1.f)) { if (hi == 0) al_l[r32] = (a); asm volatile("s_waitcnt lgkmcnt(0)" ::: "memory"); \
    _Pragma("unroll") for (int d = 0; d < 2; ++d) _Pragma("unroll") for (int r = 0; r < 16; ++r) o[d][r] *= al_l[crow(r, hi)]; } } while (0)
    f32x16 pA0, pA1, pB0, pB1; float alA, alB; bf16x8 pa0, pa1, pa2, pa3;
    constexpr int SE = 0, SO = 1;
    SLOAD(SE, 0); SWRITE(0, SE); __syncthreads();
    qkt(pA0, pA1, K_lds, qr, kbase); partialSM(pA0, pA1, m_reg, alA);
    SLOAD(SO, 1); SLOAD(SE, 2);
    SWRITE(1, SO); __syncthreads();
    for (int j = 1; j + 1 < NT; j += 2) {
        SBAR(); qkt(pB0, pB1, K_lds + SHM_K, qr, kbase);
        finishSM(pA0, pA1, alA, l_reg, pa0, pa1, pa2, pa3); SBAR();
        if (j + 2 < NT) SLOAD(SO, j + 2);
        SBAR();
        pv_d0(o, vb0, pa0, pa1, pa2, pa3); partialSM(pB0, pB1, m_reg, alB);
        __syncthreads(); SWRITE(0, SE);
        RESC(alB); __syncthreads();
        SBAR(); qkt(pA0, pA1, K_lds, qr, kbase);
        if (j + 1 == NT - 1) {
#pragma unroll
            for (int r = 8; r < 16; ++r) pA0[r] = -INFINITY;
#pragma unroll
            for (int r = 0; r < 16; ++r) pA1[r] = -INFINITY;
        }
        finishSM(pB0, pB1, alB, l_reg, pa0, pa1, pa2, pa3); SBAR();
        if (j + 3 < NT) SLOAD(SE, j + 3);
        SBAR();
        pv_d0(o, vb0 + SHM_V, pa0, pa1, pa2, pa3); partialSM(pA0, pA1, m_reg, alA);
        __syncthreads(); if (j + 2 < NT) SWRITE(1, SO);
        RESC(alA); __syncthreads();
    }
    finishSM(pA0, pA1, alA, l_reg, pa0, pa1, pa2, pa3); SBAR();
    pv_d0(o, vb0, pa0, pa1, pa2, pa3);
    if (hi == 0) li_l[r32] = l_reg; asm volatile("s_waitcnt lgkmcnt(0)" ::: "memory");
    float rli[16];
#pragma unroll
    for (int r = 0; r < 16; ++r) rli[r] = __builtin_amdgcn_rcpf(li_l[crow(r, hi)]);
    float* stg = (float*)(lds + OFF_OST + wid * OST_WAVE);
#pragma unroll
    for (int r = 0; r < 16; ++r) { const int orow = crow(r, hi);
#pragma unroll
        for (int d0 = 0; d0 < 2; ++d0) stg[orow * 68 + d0 * 32 + r32] = o[d0][r] * rli[r]; }
    asm volatile("s_waitcnt lgkmcnt(0)" ::: "memory");
    { const int row = lane >> 1, half = lane & 1; const float* s = stg + row * 68 + half * 32; f32x4 v[8]; float ss = 0.f;
#pragma unroll
      for (int i = 0; i < 8; ++i) { v[i] = *(const f32x4*)(s + 4 * i); ss += (v[i][0] * v[i][0] + v[i][1] * v[i][1]) + (v[i][2] * v[i][2] + v[i][3] * v[i][3]); }
      ss += __shfl_xor(ss, 1);
      bf16_t* dst = MIX + (size_t)(xr0 + row) * 1024 + h * 64 + half * 32;
#pragma unroll
      for (int i = 0; i < 4; ++i) *(u32x4*)(dst + 8 * i) = pack8(v[2 * i], v[2 * i + 1]);
      if (half == 0) PARTA[(size_t)(xr0 + row) * 8 + h] = ss; }
    __syncthreads();
#undef SLOAD
#undef SWRITE
#undef RESC
}
#undef SBAR
}

template <int MID> __device__ __forceinline__ int srccol(int n) {
    if (MID == 0) { if (n < 640) return n; if (n < 1152) return n + 32; if (n < 1184) { const int t = n - 1152; return 640 + ((t & 1) ? 16 + (t >> 1) : (t >> 1)); } return -1; }
    if (MID == 1) { const int h = n / 96, t = n % 96; if (t < 64) return n; const int tt = t - 64; return h * 96 + 64 + ((tt & 1) ? 16 + (tt >> 1) : (tt >> 1)); }
    if (MID == 2) { if (n < 512) return (n >> 6) * 128 + (n & 63); const int mm = n - 512; return (mm >> 6) * 128 + 64 + (mm & 63); }
    if (MID == 3) { const int q = n >> 3, t = n & 7; return t < 4 ? 4 * q + t : 512 + 4 * q + (t - 4); }
    return n;
}
template <int MID> __device__ __forceinline__ void transpose_item(const float* W, int K, int N, int Nsrc, const float* kscale, bf16_t* WT, LAS float* scr, int item, int lane) {
    const int nblk = N / 32, kb = item / nblk, nb = item % nblk, k0 = 64 * kb, n0 = 32 * nb;
    const int src = srccol<MID>(n0 + (lane & 31));
#pragma unroll 8
    for (int i = 0; i < 32; ++i) { const int kk = 2 * i + (lane >> 5); float v = src >= 0 ? W[(size_t)(k0 + kk) * Nsrc + src] : 0.f; if (kscale) v *= kscale[k0 + kk]; scr[kk * 33 + (lane & 31)] = v; }
    LDS_WAIT(); asm volatile("" ::: "memory");
    const int c = lane & 7;
#pragma unroll
    for (int j = 0; j < 4; ++j) { const int n = (lane >> 3) + 8 * j; const LAS float* s = scr + (8 * c) * 33 + n;
        u32x4 o; o.x = cvt_pk_bf16(s[0 * 33], s[1 * 33]); o.y = cvt_pk_bf16(s[2 * 33], s[3 * 33]); o.z = cvt_pk_bf16(s[4 * 33], s[5 * 33]); o.w = cvt_pk_bf16(s[6 * 33], s[7 * 33]);
        *(u32x4*)(WT + (size_t)(n0 + n) * K + k0 + 8 * c) = o; }
    LDS_WAIT(); asm volatile("" ::: "memory");
}
__device__ __forceinline__ void lam_pow(float lr, float li, float dt, float k, float& re, float& im) {
    const float mag = __expf(lr * dt * k);
    double t = (double)li * (double)dt * (double)k * 0.15915494309189535; t -= __builtin_rint(t);
    const float f = (float)t;
    re = mag * __builtin_amdgcn_cosf(f); im = mag * __builtin_amdgcn_sinf(f);
}
struct SsmP { float lr, li, dt, qr, qi; };
__device__ __forceinline__ SsmP ssm_params(const float* A_re, const float* A_im, const float* log_dt, int dir, int g, int p) {
    SsmP s; s.lr = fminf(A_re[(dir * 32 + g) * 64 + p], -1e-4f); s.li = A_im[(dir * 32 + g) * 64 + p]; s.dt = __expf(log_dt[dir * 32 + g]);
    float br, bi; lam_pow(s.lr, s.li, s.dt, 1.f, br, bi);
    const float nr = br - 1.f, ni = bi, den = 1.0f / (s.lr * s.lr + s.li * s.li);
    s.qr = (nr * s.lr + ni * s.li) * den; s.qi = (ni * s.lr - nr * s.li) * den; return s;
}

struct Args {
    const float *x, *meta, *g_pre_mix, *w_in, *g_q_lat, *w_uq, *g_kv_lat, *w_ukv, *A_re, *A_im, *log_dt, *B_re, *B_im, *C_re, *C_im, *Dv, *w_glu, *g_mix_out, *w_out, *g_post_mix, *g_pre_mlp, *w_up, *w_down, *g_post_mlp;
    const int* positions; float* out; unsigned char* ws;
};

__global__ void __launch_bounds__(NTHR, 2) fwd_megakernel(Args a) {
    extern __shared__ __attribute__((aligned(16))) unsigned char lds_raw[];
    cg::grid_group grid = cg::this_grid();
    LAS unsigned char* lds = (LAS unsigned char*)lds_raw;
    const int tid = threadIdx.x, lane = tid & 63, wave = __builtin_amdgcn_readfirstlane(tid >> 6);
    const int G = gridDim.x, bid = blockIdx.x;
    const int gw = bid * NWAVES + wave, NGW = G * NWAVES;
    const int gt = bid * NTHR + tid, NGT = G * NTHR;
    typedef const __attribute__((address_space(4))) Args* ArgP;
    const ArgP ap0 = (ArgP)__builtin_amdgcn_kernarg_segment_ptr();
#define ARGS_FRESH() ArgP ap = ap0; asm volatile("" : "+s"(ap))
    unsigned char* ws = ap0->ws;
#define P_Win ((bf16_t*)(ws + WS_WIN))
#define P_Wuq ((bf16_t*)(ws + WS_WUQ))
#define P_Wukv ((bf16_t*)(ws + WS_WUKV))
#define P_Wglu ((bf16_t*)(ws + WS_WGLU))
#define P_Wout ((bf16_t*)(ws + WS_WOUT))
#define P_Wup ((bf16_t*)(ws + WS_WUP))
#define P_Wdn ((bf16_t*)(ws + WS_WDN))
#define P_Bst ((bf16_t*)(ws + WS_BST))
#define P_Mout ((bf16_t*)(ws + WS_MOUT))
#define P_KTAB ((float*)(ws + WS_KTAB))
#define P_TAB ((float*)(ws + WS_TAB))
#define P_PART ((float*)(ws + WS_PART))
#define P_PARTA ((float*)(ws + WS_PARTA))
#define P_PARTS ((float*)(ws + WS_PARTS))
#define P_UM ((float*)(ws + WS_UM))
#define P_XN ((bf16_t*)(ws + WS_XN))
#define P_CQ ((bf16_t*)(ws + WS_CQ))
#define P_CKV ((bf16_t*)(ws + WS_CKV))
#define P_UP ((bf16_t*)(ws + WS_UP))
#define P_Q ((bf16_t*)(ws + WS_Q))
#define P_KN ((bf16_t*)(ws + WS_KN))
#define P_VV ((bf16_t*)(ws + WS_VV))
#define P_KR ((bf16_t*)(ws + WS_KR))
#define P_Sst ((float*)(ws + WS_S))
#define P_MIX ((bf16_t*)(ws + WS_MIX))
#define P_Y ((bf16_t*)(ws + WS_Y))
#define P_XN2 ((bf16_t*)(ws + WS_XN2))
#define P_H ((bf16_t*)(ws + WS_H))
#define P_V1 ((float*)(ws + WS_V1))
#define P_M2 ((float*)(ws + WS_M2))

    {
        ARGS_FRESH();
        LAS float* scr = (LAS float*)(lds + wave * 16384);
        constexpr int I0 = 16 * 40, I1 = 6 * 24, I2 = 4 * 32, I3 = 8 * 32, I4 = 16 * 32, I5 = 16 * 128, I6 = 64 * 32;
        constexpr int NITEMS = I0 + I1 + I2 + I3 + I4 + I5 + I6;
        for (int it = gw; it < NITEMS; it += NGW) {
            int r = it;
            if (r < I0) { transpose_item<0>(ap->w_in, 1024, 1280, 1184, nullptr, P_Win, scr, r, lane); continue; } r -= I0;
            if (r < I1) { transpose_item<1>(ap->w_uq, 384, 768, 768, ap->g_q_lat, P_Wuq, scr, r, lane); continue; } r -= I1;
            if (r < I2) { transpose_item<2>(ap->w_ukv, 256, 1024, 1024, ap->g_kv_lat, P_Wukv, scr, r, lane); continue; } r -= I2;
            if (r < I3) { transpose_item<3>(ap->w_glu, 512, 1024, 1024, nullptr, P_Wglu, scr, r, lane); continue; } r -= I3;
            if (r < I4) { transpose_item<4>(ap->w_out, 1024, 1024, 1024, ap->g_mix_out, P_Wout, scr, r, lane); continue; } r -= I4;
            if (r < I5) { transpose_item<5>(ap->w_up, 1024, 4096, 4096, nullptr, P_Wup, scr, r, lane); continue; } r -= I5;
            transpose_item<6>(ap->w_down, 4096, 1024, 1024, nullptr, P_Wdn, scr, r, lane);
        }
        for (int m = gw; m < MX + NMETA; m += NGW) {
            const float* xr = m < MX ? ap->x + (size_t)m * DM : ap->meta + (size_t)(m - MX) * DM;
            f32x4 v[4]; float s = 0.f;
#pragma unroll
            for (int j = 0; j < 4; ++j) { v[j] = *(const f32x4*)(xr + 4 * lane + 256 * j); s += (v[j][0] * v[j][0] + v[j][1] * v[j][1]) + (v[j][2] * v[j][2] + v[j][3] * v[j][3]); }
            const float rstd = __builtin_amdgcn_rsqf(wave_sum(s) * (1.f / DM) + EPS);
#pragma unroll
            for (int j = 0; j < 4; ++j) { const f32x4 gg = *(const f32x4*)(ap->g_pre_mix + 4 * lane + 256 * j); const f32x4 o = v[j] * rstd * gg;
                u32x2 w; w.x = cvt_pk_bf16(o[0], o[1]); w.y = cvt_pk_bf16(o[2], o[3]); *(u32x2*)(P_XN + (size_t)m * DM + 4 * lane + 256 * j) = w; }
        }
        for (int id = gt; id < (MX + NMETA) * 16; id += NGT) {
            const int row = id >> 4, p = id & 15;
            const int pos = row < MX ? ap->positions[row] + NMETA : row - MX;
            const float invq[4] = {1.0f, 0.5623413251903491f, 0.31622776601683794f, 0.1778279410038923f};
            const float dec[4] = {1.0f, 0.1f, 0.01f, 0.001f};
            const float inv = invq[p & 3] * dec[p >> 2];
            const float ang = (float)pos * inv;
            double t = (double)ang * 0.15915494309189535; t -= __builtin_rint(t); const float f = (float)t;
            P_TAB[(size_t)row * 32 + p] = __builtin_amdgcn_cosf(f); P_TAB[(size_t)row * 32 + 16 + p] = __builtin_amdgcn_sinf(f);
        }
        for (int un = gw; un < 32 * 2 * 32; un += NGW) {
            const int d = un & 31, dir = (un >> 5) & 1, g = un >> 6, p = lane;
            const SsmP sp = ssm_params(ap->A_re, ap->A_im, ap->log_dt, dir, g, p);
            float wr_, wi_; lam_pow(sp.lr, sp.li, sp.dt, (float)d, wr_, wi_);
            const float wqr = wr_ * sp.qr - wi_ * sp.qi, wqi = wr_ * sp.qi + wi_ * sp.qr;
            const float* Br = ap->B_re + ((size_t)(dir * 32 + g) * 64 + p) * 16; const float* Bi = ap->B_im + ((size_t)(dir * 32 + g) * 64 + p) * 16;
#pragma unroll
            for (int hh = 0; hh < 16; ++hh) { const float br = Br[hh], bi = Bi[hh]; scr[(p * 16 + hh) * 2] = wqr * br - wqi * bi; scr[(p * 16 + hh) * 2 + 1] = wqr * bi + wqi * br; }
            LDS_WAIT(); asm volatile("" ::: "memory");
            const int h = lane >> 2, hp0 = (lane & 3) * 4;
            const float* Cr = ap->C_re + ((size_t)(dir * 32 + g) * 16 + h) * 64; const float* Ci = ap->C_im + ((size_t)(dir * 32 + g) * 16 + h) * 64;
            f32x4 accv = {0.f, 0.f, 0.f, 0.f};
            for (int pp = 0; pp < 64; ++pp) { const float cr = Cr[pp], ci = Ci[pp];
#pragma unroll
                for (int e = 0; e < 4; ++e) accv[e] += cr * scr[(pp * 16 + hp0 + e) * 2] - ci * scr[(pp * 16 + hp0 + e) * 2 + 1]; }
            *(f32x4*)(P_KTAB + ((size_t)((g * 2 + dir) * 32 + d)) * 256 + lane * 4) = accv;
            LDS_WAIT(); asm volatile("" ::: "memory");
        }
        for (int id = gt; id < 32 * 2 * 32 * 64; id += NGT) {
            const int p = id & 63, j = (id >> 6) & 31, dir = (id >> 11) & 1, g = id >> 12;
            const SsmP sp = ssm_params(ap->A_re, ap->A_im, ap->log_dt, dir, g, p);
            {
                float wr_, wi_; lam_pow(sp.lr, sp.li, sp.dt, dir == 0 ? (float)(31 - j) : (float)j, wr_, wi_);
                const float wqr = wr_ * sp.qr - wi_ * sp.qi, wqi = wr_ * sp.qi + wi_ * sp.qr;
                const float* Br = ap->B_re + ((size_t)(dir * 32 + g) * 64 + p) * 16; const float* Bi = ap->B_im + ((size_t)(dir * 32 + g) * 64 + p) * 16;
                float er[16], ei[16];
#pragma unroll
                for (int hh = 0; hh < 16; ++hh) { const float br = Br[hh], bi = Bi[hh]; er[hh] = wqr * br - wqi * bi; ei[hh] = wqr * bi + wqi * br; }
                bf16_t* dre = P_Bst + ((size_t)(g * 256 + dir * 128 + p)) * 512 + j * 16; bf16_t* dim_ = dre + (size_t)64 * 512;
                u32x4 w;
                w.x = cvt_pk_bf16(er[0], er[1]); w.y = cvt_pk_bf16(er[2], er[3]); w.z = cvt_pk_bf16(er[4], er[5]); w.w = cvt_pk_bf16(er[6], er[7]); *(u32x4*)dre = w;
                w.x = cvt_pk_bf16(er[8], er[9]); w.y = cvt_pk_bf16(er[10], er[11]); w.z = cvt_pk_bf16(er[12], er[13]); w.w = cvt_pk_bf16(er[14], er[15]); *(u32x4*)(dre + 8) = w;
                w.x = cvt_pk_bf16(ei[0], ei[1]); w.y = cvt_pk_bf16(ei[2], ei[3]); w.z = cvt_pk_bf16(ei[4], ei[5]); w.w = cvt_pk_bf16(ei[6], ei[7]); *(u32x4*)dim_ = w;
                w.x = cvt_pk_bf16(ei[8], ei[9]); w.y = cvt_pk_bf16(ei[10], ei[11]); w.z = cvt_pk_bf16(ei[12], ei[13]); w.w = cvt_pk_bf16(ei[14], ei[15]); *(u32x4*)(dim_ + 8) = w;
            }
            {
                const int i = j; float wr_, wi_; lam_pow(sp.lr, sp.li, sp.dt, dir == 0 ? (float)(i + 1) : (float)(32 - i), wr_, wi_);
                const float* Cr = ap->C_re + ((size_t)(dir * 32 + g) * 16) * 64 + p; const float* Ci = ap->C_im + ((size_t)(dir * 32 + g) * 16) * 64 + p;
                bf16_t* d0 = P_Mout + ((size_t)(g * 512 + i * 16)) * 768 + 512 + dir * 128 + p;
#pragma unroll
                for (int hh = 0; hh < 16; ++hh) { const float cr = Cr[hh * 64], ci = Ci[hh * 64]; const float zr = cr * wr_ - ci * wi_, zi = cr * wi_ + ci * wr_;
                    d0[(size_t)hh * 768] = f2bf(zr); d0[(size_t)hh * 768 + 64] = f2bf(-zi); }
            }
        }
        for (int id = gt; id < NB * 48 * 64; id += NGT) { const int c = id & 63, r = (id >> 6) % 48, b = id / (48 * 64); const size_t row = (size_t)b * KVR + SEQ + NMETA + r;
            const u32x4 z = {0u, 0u, 0u, 0u}; *(u32x4*)(P_KN + row * 512 + c * 8) = z; *(u32x4*)(P_VV + row * 512 + c * 8) = z; if (c < 4) *(u32x4*)(P_KR + row * 32 + c * 8) = z; }
    }
    grid.sync();

    {
        ARGS_FRESH();
        for (int id = gt; id < 32 * 32 * 16 * 32 * 2; id += NGT) {
            const int h8 = id & 1, j = (id >> 1) & 31, h = (id >> 6) & 15, i = (id >> 10) & 31, g = id >> 15;
            const float* kf = P_KTAB + ((size_t)((g * 2 + 0) * 32)) * 256 + h * 16 + h8 * 8; const float* kb = P_KTAB + ((size_t)((g * 2 + 1) * 32)) * 256 + h * 16 + h8 * 8;
            f32x4 v0, v1;
            if (j < i) { const float* s = kf + (size_t)(i - j) * 256; v0 = *(const f32x4*)s; v1 = *(const f32x4*)(s + 4); }
            else if (j > i) { const float* s = kb + (size_t)(j - i) * 256; v0 = *(const f32x4*)s; v1 = *(const f32x4*)(s + 4); }
            else { v0 = *(const f32x4*)kf + *(const f32x4*)kb; v1 = *(const f32x4*)(kf + 4) + *(const f32x4*)(kb + 4);
                const float dd = ap->Dv[g * 16 + h]; const int e = h - h8 * 8; if (e >= 0 && e < 4) v0[e] += dd; else if (e >= 4 && e < 8) v1[e - 4] += dd; }
            *(u32x4*)(P_Mout + ((size_t)(g * 512 + i * 16 + h)) * 768 + j * 16 + h8 * 8) = pack8(v0, v1);
        }
        pg8::Gemm g{P_XN, P_Win, 1024, 1024, 1024, 0, 0}; pg8::Order S; S.init(MT / 256, 5, 1, G, bid);
        EpiProj E{P_CQ, P_CKV, P_UP, P_KR, P_PART, P_UM, P_TAB};
        pg8::gemm_phase<EpiProj, true>(lds, g, S, E);
    }
    grid.sync();

    {
        { pg8::Gemm g{P_CQ, P_Wuq, 384, 384, 384, 0, 0}; pg8::Order S; S.init(MX / 256, 3, 1, G, bid);
          EpiQ E{P_Q, P_PART, P_TAB}; pg8::gemm_phase<EpiQ, true>(lds, g, S, E); }
        { pg8::Gemm g{P_CKV, P_Wukv, 256, 256, 256, 0, 0}; pg8::Order S; S.init(MT / 256, 4, 1, G, (bid + 128) % G);
          EpiKV E{P_KN, P_VV, P_PART}; pg8::gemm_phase<EpiKV, true>(lds, g, S, E); }
        { pg8::Gemm g{P_UP, P_Bst, 768, 512, 512, (size_t)NCH * 768, (size_t)256 * 512}; pg8::Order S; S.init(NCH / 256, 1, 32, G, (bid + 128) % G);
          EpiState E{P_Sst}; pg8::gemm_phase<EpiState, true>(lds, g, S, E); }
    }
    grid.sync();

    {
        LAS float* sl = (LAS float*)lds;
        ARGS_FRESH();
        for (int idx = bid; idx < NB * 2 * 32; idx += G) {
            const int g = idx & 31, dir = (idx >> 5) & 1, b = idx >> 6, p = lane;
            const SsmP sp = ssm_params(ap->A_re, ap->A_im, ap->log_dt, dir, g, p);
            float aTr, aTi; lam_pow(sp.lr, sp.li, sp.dt, 32.f, aTr, aTi);
            float aSr, aSi; lam_pow(sp.lr, sp.li, sp.dt, 1024.f, aSr, aSi);
            const int c0 = b * 256 + wave * 32;
            float sre[32], sim[32];
#pragma unroll
            for (int k = 0; k < 32; ++k) { const float* s = P_Sst + ((size_t)g * NCH + c0 + k) * 256 + dir * 128 + p; sre[k] = s[0]; sim[k] = s[64]; }
            float xr = 0.f, xi = 0.f;
            if (dir == 0) {
#pragma unroll
                for (int k = 0; k < 32; ++k) { const float nr = aTr * xr - aTi * xi + sre[k], ni = aTr * xi + aTi * xr + sim[k]; xr = nr; xi = ni; }
            } else {
#pragma unroll
                for (int k = 31; k >= 0; --k) { const float nr = aTr * xr - aTi * xi + sre[k], ni = aTr * xi + aTi * xr + sim[k]; xr = nr; xi = ni; }
            }
            sl[(wave * 64 + p) * 2] = xr; sl[(wave * 64 + p) * 2 + 1] = xi;
            __syncthreads();
            float cr = 0.f, ci = 0.f;
            if (dir == 0) {
                const float* Br = ap->B_re + ((size_t)(g) * 64 + p) * 16; const float* Bi = ap->B_im + ((size_t)(g) * 64 + p) * 16;
                for (int j = 0; j < NMETA; ++j) {
                    float ur = 0.f, ui = 0.f;
#pragma unroll
                    for (int hh = 0; hh < 16; ++hh) { const float uu = P_UM[j * 512 + g * 16 + hh]; ur += Br[hh] * uu; ui += Bi[hh] * uu; }
                    const float br = sp.qr * ur - sp.qi * ui, bi = sp.qr * ui + sp.qi * ur;
                    float pr, pi; lam_pow(sp.lr, sp.li, sp.dt, (float)(NMETA - 1 - j), pr, pi);
                    cr += pr * br - pi * bi; ci += pr * bi + pi * br;
                }
                for (int w = 0; w < wave; ++w) { const float tr = sl[(w * 64 + p) * 2], ti = sl[(w * 64 + p) * 2 + 1];
                    const float nr = aSr * cr - aSi * ci + tr, ni = aSr * ci + aSi * cr + ti; cr = nr; ci = ni; }
                xr = cr; xi = ci;
#pragma unroll
                for (int k = 0; k < 32; ++k) {
                    bf16_t* d = P_UP + ((size_t)g * NCH + c0 + k) * 768 + 512 + p; d[0] = f2bf(xr); d[64] = f2bf(xi);
                    const float nr = aTr * xr - aTi * xi + sre[k], ni = aTr * xi + aTi * xr + sim[k]; xr = nr; xi = ni; }
            } else {
                for (int w = NWAVES - 1; w > wave; --w) { const float tr = sl[(w * 64 + p) * 2], ti = sl[(w * 64 + p) * 2 + 1];
                    const float nr = aSr * cr - aSi * ci + tr, ni = aSr * ci + aSi * cr + ti; cr = nr; ci = ni; }
                xr = cr; xi = ci;
#pragma unroll
                for (int k = 31; k >= 0; --k) {
                    bf16_t* d = P_UP + ((size_t)g * NCH + c0 + k) * 768 + 512 + 128 + p; d[0] = f2bf(xr); d[64] = f2bf(xi);
                    const float nr = aTr * xr - aTi * xi + sre[k], ni = aTr * xi + aTi * xr + sim[k]; xr = nr; xi = ni; }
            }
            __syncthreads();
        }
        const int vcu = (G % 8 == 0) ? (bid % 8) * (G / 8) + bid / 8 : bid;
        for (int L = vcu; L < NB * 8 * 32; L += G) {
            const int bh = L >> 5, qb = L & 31;
            attn::attn_unit(bh >> 3, bh & 7, qb, P_Q, P_KN, P_KR, P_VV, P_MIX, P_PARTA, (char*)lds_raw);
        }
    }
    grid.sync();

    { pg8::Gemm g{P_UP, P_Mout, 768, 768, 768, (size_t)NCH * 768, (size_t)512 * 768}; pg8::Order S; S.init(NCH / 256, 2, 32, G, bid);
      EpiY E{P_Y}; pg8::gemm_phase<EpiY, true>(lds, g, S, E); }
    grid.sync();
    { pg8::Gemm g{P_Y, P_Wglu, 512, 512, 512, 0, 0}; pg8::Order S; S.init(MX / 256, 4, 1, G, bid);
      EpiGLU E{P_MIX, P_PARTS}; pg8::gemm_phase<EpiGLU, true>(lds, g, S, E); }
    grid.sync();
    { pg8::Gemm g{P_MIX, P_Wout, 1024, 1024, 1024, 0, 0}; pg8::Order S; S.init(MX / 256, 4, 1, G, bid);
      EpiWout E{P_V1, P_PARTA, P_PARTS}; pg8::gemm_phase<EpiWout, true>(lds, g, S, E); }
    grid.sync();
    { ARGS_FRESH();
    for (int m = gw; m < MX; m += NGW) {
        f32x4 v[4], xx[4]; float s = 0.f;
#pragma unroll
        for (int j = 0; j < 4; ++j) { v[j] = *(const f32x4*)(P_V1 + (size_t)m * DM + 4 * lane + 256 * j); xx[j] = *(const f32x4*)(ap->x + (size_t)m * DM + 4 * lane + 256 * j);
            s += (v[j][0] * v[j][0] + v[j][1] * v[j][1]) + (v[j][2] * v[j][2] + v[j][3] * v[j][3]); }
        const float rstd = __builtin_amdgcn_rsqf(wave_sum(s) * (1.f / DM) + EPS); float s2 = 0.f;
#pragma unroll
        for (int j = 0; j < 4; ++j) { const f32x4 gg = *(const f32x4*)(ap->g_post_mix + 4 * lane + 256 * j); v[j] = xx[j] + v[j] * rstd * gg;
            *(f32x4*)(ap->out + (size_t)m * DM + 4 * lane + 256 * j) = v[j]; s2 += (v[j][0] * v[j][0] + v[j][1] * v[j][1]) + (v[j][2] * v[j][2] + v[j][3] * v[j][3]); }
        const float rstd2 = __builtin_amdgcn_rsqf(wave_sum(s2) * (1.f / DM) + EPS);
#pragma unroll
        for (int j = 0; j < 4; ++j) { const f32x4 gg = *(const f32x4*)(ap->g_pre_mlp + 4 * lane + 256 * j); const f32x4 o = v[j] * rstd2 * gg;
            u32x2 w; w.x = cvt_pk_bf16(o[0], o[1]); w.y = cvt_pk_bf16(o[2], o[3]); *(u32x2*)(P_XN2 + (size_t)m * DM + 4 * lane + 256 * j) = w; }
    } }
    grid.sync();
    { pg8::Gemm g{P_XN2, P_Wup, 1024, 1024, 1024, 0, 0}; pg8::Order S; S.init(MX / 256, 16, 1, G, bid);
      EpiRelu2 E{P_H}; pg8::gemm_phase<EpiRelu2, true>(lds, g, S, E); }
    grid.sync();
    { pg8::Gemm g{P_H, P_Wdn, 4096, 4096, 4096, 0, 0}; pg8::Order S; S.init(MX / 256, 4, 1, G, bid);
      EpiF32 E{P_M2}; pg8::gemm_phase<EpiF32, true>(lds, g, S, E); }
    grid.sync();
    { ARGS_FRESH();
    for (int m = gw; m < MX; m += NGW) {
        f32x4 v[4]; float s = 0.f;
#pragma unroll
        for (int j = 0; j < 4; ++j) { v[j] = *(const f32x4*)(P_M2 + (size_t)m * DM + 4 * lane + 256 * j); s += (v[j][0] * v[j][0] + v[j][1] * v[j][1]) + (v[j][2] * v[j][2] + v[j][3] * v[j][3]); }
        const float rstd = __builtin_amdgcn_rsqf(wave_sum(s) * (1.f / DM) + EPS);
#pragma unroll
        for (int j = 0; j < 4; ++j) { const f32x4 gg = *(const f32x4*)(ap->g_post_mlp + 4 * lane + 256 * j); float* o = ap->out + (size_t)m * DM + 4 * lane + 256 * j;
            *(f32x4*)o = *(const f32x4*)o + v[j] * rstd * gg; }
    } }
}

extern "C" void kernel_launch(void* const* d_in, const int* in_sizes, int n_in, void* d_out, int out_size, void* d_ws, size_t ws_size, hipStream_t stream) {
    static int grid = 0;
    if (grid == 0) {
        if (n_in != 25 || out_size != MX * DM || ws_size < WS_END) { fprintf(stderr, "kernel_launch: unexpected shapes n_in %d out %d ws %zu\n", n_in, out_size, ws_size); grid = -1; return; }
        int dev = 0, cus = 0, per_cu = 0;
        (void)hipGetDevice(&dev);
        (void)hipDeviceGetAttribute(&cus, hipDeviceAttributeMultiprocessorCount, dev);
        (void)hipFuncSetAttribute((const void*)fwd_megakernel, hipFuncAttributeMaxDynamicSharedMemorySize, LDS_BYTES);
        (void)hipOccupancyMaxActiveBlocksPerMultiprocessor(&per_cu, (const void*)fwd_megakernel, NTHR, LDS_BYTES);
        if (per_cu < 1) { fprintf(stderr, "kernel_launch: occupancy query says %d\n", per_cu); grid = -1; return; }
        grid = cus * 1;
        fprintf(stderr, "kernel_launch: cus %d per_cu %d grid %d ws %zu\n", cus, per_cu, grid, ws_size);
    }
    if (grid < 0) return;
    Args a{};
    const float** fp = (const float**)&a;
    a.x = (const float*)d_in[0]; a.positions = (const int*)d_in[1]; a.meta = (const float*)d_in[2];
    a.g_pre_mix = (const float*)d_in[3]; a.w_in = (const float*)d_in[4]; a.g_q_lat = (const float*)d_in[5]; a.w_uq = (const float*)d_in[6]; a.g_kv_lat = (const float*)d_in[7]; a.w_ukv = (const float*)d_in[8];
    a.A_re = (const float*)d_in[9]; a.A_im = (const float*)d_in[10]; a.log_dt = (const float*)d_in[11]; a.B_re = (const float*)d_in[12]; a.B_im = (const float*)d_in[13]; a.C_re = (const float*)d_in[14]; a.C_im = (const float*)d_in[15];
    a.Dv = (const float*)d_in[16]; a.w_glu = (const float*)d_in[17]; a.g_mix_out = (const float*)d_in[18]; a.w_out = (const float*)d_in[19]; a.g_post_mix = (const float*)d_in[20]; a.g_pre_mlp = (const float*)d_in[21];
    a.w_up = (const float*)d_in[22]; a.w_down = (const float*)d_in[23]; a.g_post_mlp = (const float*)d_in[24];
    (void)fp;
    a.out = (float*)d_out; a.ws = (unsigned char*)d_ws;
    void* args[] = {&a};
    hipError_t e = hipLaunchCooperativeKernel((const void*)fwd_megakernel, dim3(grid), dim3(NTHR), args, LDS_BYTES, stream);
    if (e != hipSuccess) fprintf(stderr, "cooperative launch failed: %s (grid %d)\n", hipGetErrorString(e), grid);
}
```

```cpp
#include <hip/hip_runtime.h>
#include <hip/hip_cooperative_groups.h>
#include <cstdio>
#include <cstdint>
namespace cg = cooperative_groups;
#define PROBE_A (-1)
#define PROBE_B 0

#define LAS __attribute__((address_space(3)))
typedef unsigned short bf16_t;
typedef short bf16x8 __attribute__((ext_vector_type(8)));
typedef short s16x4 __attribute__((ext_vector_type(4)));
typedef float f32x4 __attribute__((ext_vector_type(4)));
typedef float f32x2 __attribute__((ext_vector_type(2)));
typedef float f32x16 __attribute__((ext_vector_type(16)));
typedef unsigned u32x4 __attribute__((ext_vector_type(4)));
typedef unsigned u32x2 __attribute__((ext_vector_type(2)));

constexpr int NB = 4, SEQ = 8192, NMETA = 16, DM = 1024, DFF = 4096;
constexpr int MX = NB * SEQ;
constexpr int MT = MX + 256;
constexpr int KVR = 8256;
constexpr int NCH = 1024;
constexpr float EPS = 1e-6f;
constexpr int NWAVES = 8, NTHR = 512;
constexpr int LDS_BYTES = 147456;
constexpr int TAB_OFF = 131072;
constexpr int XBST_OFF = LDS_BYTES - 64;
constexpr float QSCALE = 0.10206207261596577f * 1.4426950408889634f;

constexpr size_t MiB = 1u << 20;
constexpr size_t WS_UM = 512 * 1024;
constexpr size_t WS_WIN = 1 * MiB, WS_WUQ = 4 * MiB, WS_WUKV = 5 * MiB, WS_WGLU = 6 * MiB, WS_WOUT = 7 * MiB, WS_WUP = 9 * MiB, WS_WDN = 17 * MiB;
constexpr size_t WS_BST = 25 * MiB, WS_MOUT = 33 * MiB, WS_KTAB = 57 * MiB, WS_TAB = 59 * MiB, WS_PART = 64 * MiB, WS_PARTA = 67 * MiB, WS_PARTS = 68 * MiB;
constexpr size_t WS_XN = 72 * MiB, WS_CQ = 137 * MiB  , WS_UP = 188 * MiB, WS_S = 236 * MiB, WS_Q = 268 * MiB, WS_KN = 316 * MiB, WS_VV = 349 * MiB, WS_KR = 382 * MiB;
constexpr size_t WS_MIX = 392 * MiB, WS_Y = 456 * MiB;
constexpr size_t WS_V1 = 72 * MiB, WS_XN2 = 328 * MiB, WS_H = 72 * MiB, WS_M2 = 328 * MiB, WS_END = 488 * MiB;

__device__ __forceinline__ unsigned cvt_pk_bf16(float lo, float hi) { unsigned r; asm volatile("v_cvt_pk_bf16_f32 %0, %1, %2" : "=v"(r) : "v"(lo), "v"(hi)); return r; }
__device__ __forceinline__ bf16_t f2bf(float f) { return (bf16_t)(cvt_pk_bf16(f, 0.f) & 0xffffu); }
__device__ __forceinline__ u32x4 pack8(f32x4 a, f32x4 b) { u32x4 w; w.x = cvt_pk_bf16(a[0], a[1]); w.y = cvt_pk_bf16(a[2], a[3]); w.z = cvt_pk_bf16(b[0], b[1]); w.w = cvt_pk_bf16(b[2], b[3]); return w; }
__device__ __forceinline__ float wave_sum(float v) {
#pragma unroll
    for (int o = 1; o < 64; o <<= 1) v += __shfl_xor(v, o);
    return v;
}
#define LDS_WAIT() asm volatile("s_waitcnt lgkmcnt(0)" ::: "memory")
__device__ __forceinline__ int tid_of(int wave) { return wave * 64 + (int)__builtin_amdgcn_mbcnt_hi(~0u, __builtin_amdgcn_mbcnt_lo(~0u, 0u)); }

namespace pg8 {
constexpr int BM = 256, BK = 64, HALF = 128, HTB = HALF * BK * 2, STAGE_BYTES = 8 * HTB, NXCD = 8, WGM = 8;
__device__ __forceinline__ int lds_byte(int r, int c) { const int st = (r >> 4) * 2 + (c >> 5), rr = r & 15, cc = c & 31, ob = rr * 64 + cc * 2; return st * 1024 + (ob ^ (((ob >> 9) & 1) << 5)); }
__device__ __forceinline__ void stage_rc(int b, int& R, int& C) { const int st = b / 1024, sb = b % 1024, swz = sb ^ (((sb >> 9) & 1) << 5); R = (st >> 1) * 16 + swz / 64; C = (st & 1) * 32 + (swz % 64) / 2; }
__device__ __forceinline__ int perm32(int rho) { const int n = rho >> 4, i = rho & 15; return 8 * (i >> 2) + 4 * n + (i & 3); }

struct Unit { int pm, pn, pg, ui, ty; };
struct Gemm { const bf16_t* A; const bf16_t* Bt; int lda, ldb, K; size_t gsA, gsB; };

struct Order {
    int nM, nN, per, nwg, G, c, rev = 0;
    __device__ __forceinline__ void init(int nM_, int nN_, int nG_, int G_, int c_) { nM = nM_; nN = nN_; per = nM_ * nN_; nwg = per * nG_; G = G_; c = c_; }
    __device__ __forceinline__ bool next(int i, Unit& u) const { const int nr = (nwg + G - 1) / G; if (i >= nr) return false;
        const bool rv = rev && (nwg % G == 0);
        return decode((long)(rv ? nr - 1 - i : i) * G + c, u); }
    __device__ __forceinline__ bool decode(long L, Unit& u) const {
        if (L >= nwg) return false;
        int wgid = (int)L; { const int q = nwg / NXCD, r = nwg % NXCD, xcd = wgid % NXCD, off = wgid / NXCD; wgid = (xcd < r ? xcd * (q + 1) : r * (q + 1) + (xcd - r) * q) + off; }
        const int pg = wgid / per, w = wgid % per;
        const int nig = WGM * nN, gid = w / nig, fm = gid * WGM, gsz = (nM - fm) < WGM ? (nM - fm) : WGM;
        u.pm = fm + ((w % nig) % gsz); u.pn = (w % nig) / gsz; u.pg = pg; return true;
    }
};

template <class Epi, bool ALIGN_EPI>
__device__ __forceinline__ void gemm_phase(LAS unsigned char* lds, const Gemm g, const Order& S, const Epi& E, const int wid) {
    int tid = tid_of(wid); asm volatile("" : "+v"(tid));
    const int lane = tid & 63, wr = wid >> 2, wc = wid & 3; int fr = lane & 15, fq = lane >> 4;
    const int K = g.K, nt = K / BK;
    unsigned voffA[2], voffB[2];
#pragma unroll
    for (int i = 0; i < 2; ++i) { int R, C; stage_rc(tid * 16 + i * 8192, R, C); const int Rb = Epi::PERM ? ((R & ~31) + perm32(R & 31)) : R;
        voffA[i] = (unsigned)(R * g.lda + C) * 2u; voffB[i] = (unsigned)(Rb * g.ldb + C) * 2u; }
    const size_t kstep = (size_t)(BK * 2);
    const size_t hstepA = (size_t)HALF * g.lda * 2, hstepB = (size_t)HALF * g.ldb * 2;
    const size_t tstepA = 2 * hstepA, tstepB = 2 * hstepB;
    const unsigned ldsw = (unsigned)wid * 1024u;
    const int aoff = lds_byte(wr * 64 + fr, fq * 8), boff = lds_byte(wc * 32 + fr, fq * 8);
#define PG8_SA(b, h) (((b) * 2 + (h)) * HTB)
#define PG8_SB(b, h) ((4 + (b) * 2 + (h)) * HTB)
#define PG8_STAGE(bufoff, gbase, voff) do { _Pragma("unroll") for (int _i = 0; _i < 2; ++_i) \
        __builtin_amdgcn_global_load_lds((const unsigned*)((const char*)(gbase) + (voff)[_i]), (LAS unsigned*)(lds + (bufoff) + ldsw + _i * 8192), 16, 0, 0); } while (0)
#define PG8_LDA(dst, b, h) do { _Pragma("unroll") for (int m = 0; m < 4; ++m) _Pragma("unroll") for (int k = 0; k < 2; ++k) dst[m][k] = *(const LAS bf16x8*)(lds + PG8_SA(b, h) + aoff + m * 2048 + k * 1024); } while (0)
#define PG8_LDB(dst, b, h) do { _Pragma("unroll") for (int n = 0; n < 2; ++n) _Pragma("unroll") for (int k = 0; k < 2; ++k) dst[n][k] = *(const LAS bf16x8*)(lds + PG8_SB(b, h) + boff + n * 2048 + k * 1024); } while (0)
#define PG8_MMA(ai, bj, At, Bt) do { __builtin_amdgcn_s_setprio(1); _Pragma("unroll") for (int m = 0; m < 4; ++m) _Pragma("unroll") for (int n = 0; n < 2; ++n) _Pragma("unroll") for (int k = 0; k < 2; ++k) \
        acc[ai][bj][m][n] = __builtin_amdgcn_mfma_f32_16x16x32_bf16(Bt[n][k], At[m][k], acc[ai][bj][m][n], 0, 0, 0); __builtin_amdgcn_s_setprio(0); } while (0)
#define PG8_WAIT_V(n) asm volatile("s_waitcnt vmcnt(" #n ")" ::: "memory")
#define PG8_WAIT_L(n) asm volatile("s_waitcnt lgkmcnt(" #n ")" ::: "memory")
#define PG8_BAR __builtin_amdgcn_s_barrier()
#define PG8_SCHED __builtin_amdgcn_sched_barrier(0)
    Unit cur, nxt; int ui = 0;
    if (!S.next(0, cur)) return;
    cur.ui = 0;
    f32x4 acc[2][2][4][2];
#pragma unroll
    for (int a = 0; a < 2; ++a)
#pragma unroll
        for (int b = 0; b < 2; ++b)
#pragma unroll
            for (int m = 0; m < 4; ++m)
#pragma unroll
                for (int n = 0; n < 2; ++n) acc[a][b][m][n] = (f32x4){0.f, 0.f, 0.f, 0.f};
    bf16x8 At[4][2], B0[2][2], B1[2][2];
    bool fresh = false;
    const char* cA = (const char*)g.A + ((size_t)cur.pg * g.gsA) * 2 + (size_t)cur.pm * tstepA; const char* cB = (const char*)g.Bt + ((size_t)cur.pg * g.gsB) * 2 + (size_t)cur.pn * tstepB;
    PG8_STAGE(PG8_SB(0, 0), cB, voffB); PG8_STAGE(PG8_SB(0, 1), cB + hstepB, voffB); PG8_STAGE(PG8_SA(0, 0), cA, voffA); PG8_STAGE(PG8_SA(0, 1), cA + hstepA, voffA);
    if (wr == 1) PG8_BAR;
    PG8_WAIT_V(2); PG8_BAR;
    PG8_STAGE(PG8_SB(1, 0), cB + kstep, voffB); PG8_STAGE(PG8_SA(1, 0), cA + kstep, voffA); PG8_STAGE(PG8_SB(1, 1), cB + hstepB + kstep, voffB);
    PG8_WAIT_V(6); PG8_BAR;
    for (;;) {
        const bool has_next = S.next(ui + 1, nxt); nxt.ui = ui + 1;
        const char* nA = has_next ? (const char*)g.A + ((size_t)nxt.pg * g.gsA) * 2 + (size_t)nxt.pm * tstepA : cA;
        const char* nB = has_next ? (const char*)g.Bt + ((size_t)nxt.pg * g.gsB) * 2 + (size_t)nxt.pn * tstepB : cB;
#pragma unroll 1
        for (int t = 0; t < nt; t += 2) {
            if constexpr (Epi::MID) { if (t == (nt >> 1)) E.mid(acc, cur, wr, wc, fr, fq); }
            const bool last = (t == nt - 2);
            const char* a1 = cA + (size_t)(t + 1) * kstep;
            const char* a2 = last ? nA : cA + (size_t)(t + 2) * kstep; const char* b2 = last ? nB : cB + (size_t)(t + 2) * kstep;
            const char* a3 = a2 + kstep; const char* b3 = b2 + kstep;
            PG8_LDB(B0, 0, 0); PG8_LDB(B1, 0, 1); PG8_SCHED; PG8_LDA(At, 0, 0); PG8_STAGE(PG8_SA(1, 1), a1 + hstepA, voffA);
            if (!fresh) PG8_WAIT_V(8); PG8_WAIT_L(0); PG8_BAR; PG8_MMA(0, 0, At, B0); PG8_MMA(0, 1, At, B1); PG8_BAR; PG8_SCHED;
            PG8_LDA(At, 0, 1); PG8_STAGE(PG8_SB(0, 0), b2, voffB); PG8_STAGE(PG8_SB(0, 1), b2 + hstepB, voffB); PG8_STAGE(PG8_SA(0, 0), a2, voffA);
            PG8_WAIT_V(8); PG8_WAIT_L(0); PG8_BAR; PG8_MMA(1, 0, At, B0); PG8_MMA(1, 1, At, B1); PG8_BAR; PG8_SCHED;
            fresh = false;
            PG8_LDB(B0, 1, 0); PG8_LDB(B1, 1, 1); PG8_SCHED; PG8_LDA(At, 1, 0); PG8_STAGE(PG8_SA(0, 1), a2 + hstepA, voffA);
            PG8_WAIT_V(8); PG8_WAIT_L(0); PG8_BAR; PG8_MMA(0, 0, At, B0); PG8_MMA(0, 1, At, B1); PG8_BAR; PG8_SCHED;
            PG8_LDA(At, 1, 1); PG8_STAGE(PG8_SB(1, 0), b3, voffB); PG8_STAGE(PG8_SB(1, 1), b3 + hstepB, voffB); PG8_STAGE(PG8_SA(1, 0), a3, voffA);
            PG8_WAIT_V(8); PG8_WAIT_L(0); PG8_BAR; PG8_MMA(1, 0, At, B0); PG8_MMA(1, 1, At, B1); PG8_BAR; PG8_SCHED;
        }
        if constexpr (ALIGN_EPI) { if (wr == 0) PG8_BAR; }
        E(acc, cur, wr, wc, fr, fq);
        if (!has_next) break;
        fresh = true;
#pragma unroll
        for (int a = 0; a < 2; ++a)
#pragma unroll
            for (int b = 0; b < 2; ++b)
#pragma unroll
                for (int m = 0; m < 4; ++m)
#pragma unroll
                    for (int n = 0; n < 2; ++n) acc[a][b][m][n] = (f32x4){0.f, 0.f, 0.f, 0.f};
        cur = nxt; cA = nA; cB = nB; ++ui;
        if constexpr (ALIGN_EPI) { if (wr == 1) PG8_BAR; }
    }
    PG8_WAIT_V(0);
    if constexpr (!ALIGN_EPI) { if (wr == 0) PG8_BAR; }
    PG8_BAR;
#undef PG8_SA
#undef PG8_SB
#undef PG8_STAGE
#undef PG8_LDA
#undef PG8_LDB
#undef PG8_MMA
#undef PG8_WAIT_V
#undef PG8_WAIT_L
#undef PG8_BAR
#undef PG8_SCHED
}
#define SEL3(arr, t) ((t) == 0 ? (arr)[0] : (t) == 1 ? (arr)[1] : (arr)[2])
struct EpiPermOnly { static constexpr bool PERM = true, MID = false; };
struct Gemm3 { const bf16_t* A[3]; const bf16_t* Bt[3]; int nt[3]; size_t gsA[3], gsB[3]; int lda, ldb; };
template <class Sched, class E0, class E1, class E2, bool ALIGN_EPI, class Epi = EpiPermOnly>
__device__ __forceinline__ void gemm_phase_multi(LAS unsigned char* lds, const Gemm3 g, const Sched& S, const E0& e0, const E1& e1, const E2& e2, const int wid) {
    static_assert(E0::PERM && E1::PERM && E2::PERM && !E0::MID && !E1::MID && !E2::MID, "multi stream: permuted layout, no mid-K hooks");
    int tid = tid_of(wid); asm volatile("" : "+v"(tid));
    const int lane = tid & 63, wr = wid >> 2, wc = wid & 3; int fr = lane & 15, fq = lane >> 4;
    unsigned voffA[2], voffB[2];
#pragma unroll
    for (int i = 0; i < 2; ++i) { int R, C; stage_rc(tid * 16 + i * 8192, R, C); const int Rb = Epi::PERM ? ((R & ~31) + perm32(R & 31)) : R;
        voffA[i] = (unsigned)(R * g.lda + C) * 2u; voffB[i] = (unsigned)(Rb * g.ldb + C) * 2u; }
    const size_t kstep = (size_t)(BK * 2);
    const size_t hstepA = (size_t)HALF * g.lda * 2, hstepB = (size_t)HALF * g.ldb * 2;
    const size_t tstepA = 2 * hstepA, tstepB = 2 * hstepB;
    const unsigned ldsw = (unsigned)wid * 1024u;
    const int aoff = lds_byte(wr * 64 + fr, fq * 8), boff = lds_byte(wc * 32 + fr, fq * 8);
#define PG8_SA(b, h) (((b) * 2 + (h)) * HTB)
#define PG8_SB(b, h) ((4 + (b) * 2 + (h)) * HTB)
#define PG8_STAGE(bufoff, gbase, voff) do { _Pragma("unroll") for (int _i = 0; _i < 2; ++_i) \
        __builtin_amdgcn_global_load_lds((const unsigned*)((const char*)(gbase) + (voff)[_i]), (LAS unsigned*)(lds + (bufoff) + ldsw + _i * 8192), 16, 0, 0); } while (0)
#define PG8_LDA(dst, b, h) do { _Pragma("unroll") for (int m = 0; m < 4; ++m) _Pragma("unroll") for (int k = 0; k < 2; ++k) dst[m][k] = *(const LAS bf16x8*)(lds + PG8_SA(b, h) + aoff + m * 2048 + k * 1024); } while (0)
#define PG8_LDB(dst, b, h) do { _Pragma("unroll") for (int n = 0; n < 2; ++n) _Pragma("unroll") for (int k = 0; k < 2; ++k) dst[n][k] = *(const LAS bf16x8*)(lds + PG8_SB(b, h) + boff + n * 2048 + k * 1024); } while (0)
#define PG8_MMA(ai, bj, At, Bt) do { __builtin_amdgcn_s_setprio(1); _Pragma("unroll") for (int m = 0; m < 4; ++m) _Pragma("unroll") for (int n = 0; n < 2; ++n) _Pragma("unroll") for (int k = 0; k < 2; ++k) \
        acc[ai][bj][m][n] = __builtin_amdgcn_mfma_f32_16x16x32_bf16(Bt[n][k], At[m][k], acc[ai][bj][m][n], 0, 0, 0); __builtin_amdgcn_s_setprio(0); } while (0)
#define PG8_WAIT_V(n) asm volatile("s_waitcnt vmcnt(" #n ")" ::: "memory")
#define PG8_WAIT_L(n) asm volatile("s_waitcnt lgkmcnt(" #n ")" ::: "memory")
#define PG8_BAR __builtin_amdgcn_s_barrier()
#define PG8_SCHED __builtin_amdgcn_sched_barrier(0)
    Unit cur, nxt; int ui = 0;
    if (!S.next(0, cur)) return;
    cur.ui = 0;
    f32x4 acc[2][2][4][2];
#pragma unroll
    for (int a = 0; a < 2; ++a)
#pragma unroll
        for (int b = 0; b < 2; ++b)
#pragma unroll
            for (int m = 0; m < 4; ++m)
#pragma unroll
                for (int n = 0; n < 2; ++n) acc[a][b][m][n] = (f32x4){0.f, 0.f, 0.f, 0.f};
    bf16x8 At[4][2], B0[2][2], B1[2][2];
    bool fresh = false;
    const char* cA = (const char*)SEL3(g.A, cur.ty) + ((size_t)cur.pg * SEL3(g.gsA, cur.ty)) * 2 + (size_t)cur.pm * tstepA; const char* cB = (const char*)SEL3(g.Bt, cur.ty) + ((size_t)cur.pg * SEL3(g.gsB, cur.ty)) * 2 + (size_t)cur.pn * tstepB;
    int nt = SEL3(g.nt, cur.ty);
    PG8_STAGE(PG8_SB(0, 0), cB, voffB); PG8_STAGE(PG8_SB(0, 1), cB + hstepB, voffB); PG8_STAGE(PG8_SA(0, 0), cA, voffA); PG8_STAGE(PG8_SA(0, 1), cA + hstepA, voffA);
    if (wr == 1) PG8_BAR;
    PG8_WAIT_V(2); PG8_BAR;
    PG8_STAGE(PG8_SB(1, 0), cB + kstep, voffB); PG8_STAGE(PG8_SA(1, 0), cA + kstep, voffA); PG8_STAGE(PG8_SB(1, 1), cB + hstepB + kstep, voffB);
    PG8_WAIT_V(6); PG8_BAR;
    for (;;) {
        const bool has_next = S.next(ui + 1, nxt); nxt.ui = ui + 1;
        const char* nA = has_next ? (const char*)SEL3(g.A, nxt.ty) + ((size_t)nxt.pg * SEL3(g.gsA, nxt.ty)) * 2 + (size_t)nxt.pm * tstepA : cA;
        const char* nB = has_next ? (const char*)SEL3(g.Bt, nxt.ty) + ((size_t)nxt.pg * SEL3(g.gsB, nxt.ty)) * 2 + (size_t)nxt.pn * tstepB : cB;
#pragma unroll 1
        for (int t = 0; t < nt; t += 2) {
            const bool last = (t == nt - 2);
            const char* a1 = cA + (size_t)(t + 1) * kstep;
            const char* a2 = last ? nA : cA + (size_t)(t + 2) * kstep; const char* b2 = last ? nB : cB + (size_t)(t + 2) * kstep;
            const char* a3 = a2 + kstep; const char* b3 = b2 + kstep;
            PG8_LDB(B0, 0, 0); PG8_LDB(B1, 0, 1); PG8_SCHED; PG8_LDA(At, 0, 0); PG8_STAGE(PG8_SA(1, 1), a1 + hstepA, voffA);
            if (!fresh) PG8_WAIT_V(8); PG8_WAIT_L(0); PG8_BAR; PG8_MMA(0, 0, At, B0); PG8_MMA(0, 1, At, B1); PG8_BAR; PG8_SCHED;
            PG8_LDA(At, 0, 1); PG8_STAGE(PG8_SB(0, 0), b2, voffB); PG8_STAGE(PG8_SB(0, 1), b2 + hstepB, voffB); PG8_STAGE(PG8_SA(0, 0), a2, voffA);
            PG8_WAIT_V(8); PG8_WAIT_L(0); PG8_BAR; PG8_MMA(1, 0, At, B0); PG8_MMA(1, 1, At, B1); PG8_BAR; PG8_SCHED;
            fresh = false;
            PG8_LDB(B0, 1, 0); PG8_LDB(B1, 1, 1); PG8_SCHED; PG8_LDA(At, 1, 0); PG8_STAGE(PG8_SA(0, 1), a2 + hstepA, voffA);
            PG8_WAIT_V(8); PG8_WAIT_L(0); PG8_BAR; PG8_MMA(0, 0, At, B0); PG8_MMA(0, 1, At, B1); PG8_BAR; PG8_SCHED;
            PG8_LDA(At, 1, 1); PG8_STAGE(PG8_SB(1, 0), b3, voffB); PG8_STAGE(PG8_SB(1, 1), b3 + hstepB, voffB); PG8_STAGE(PG8_SA(1, 0), a3, voffA);
            PG8_WAIT_V(8); PG8_WAIT_L(0); PG8_BAR; PG8_MMA(1, 0, At, B0); PG8_MMA(1, 1, At, B1); PG8_BAR; PG8_SCHED;
        }
        if constexpr (ALIGN_EPI) { if (wr == 0) PG8_BAR; }
        if (cur.ty == 0) e0(acc, cur, wr, wc, fr, fq); else if (cur.ty == 1) e1(acc, cur, wr, wc, fr, fq); else e2(acc, cur, wr, wc, fr, fq);
        if (!has_next) break;
        fresh = true;
#pragma unroll
        for (int a = 0; a < 2; ++a)
#pragma unroll
            for (int b = 0; b < 2; ++b)
#pragma unroll
                for (int m = 0; m < 4; ++m)
#pragma unroll
                    for (int n = 0; n < 2; ++n) acc[a][b][m][n] = (f32x4){0.f, 0.f, 0.f, 0.f};
        cur = nxt; cA = nA; cB = nB; ++ui; nt = SEL3(g.nt, cur.ty);
        if constexpr (ALIGN_EPI) { if (wr == 1) PG8_BAR; }
    }
    PG8_WAIT_V(0);
    if constexpr (!ALIGN_EPI) { if (wr == 0) PG8_BAR; }
    PG8_BAR;
#undef PG8_SA
#undef PG8_SB
#undef PG8_STAGE
#undef PG8_LDA
#undef PG8_LDB
#undef PG8_MMA
#undef PG8_WAIT_V
#undef PG8_WAIT_L
#undef PG8_BAR
#undef PG8_SCHED
}
}
using pg8::Unit;
typedef f32x4 Acc[2][2][4][2];

__device__ __forceinline__ int kvrow_of(int row) { return (row >> 13) * KVR + (row & 8191); }

struct EpiProj {
    static constexpr bool PERM = true, MID = false;
    bf16_t *CQ, *UP, *KR; float *PART, *UM; const float* TAB; const LAS float* rt;
    __device__ __forceinline__ void operator()(const Acc& acc, const Unit& u, int wr, int wc, int fr, int fq) const {
        asm volatile("" : "+v"(fr), "+v"(fq));
#pragma unroll
        for (int bj = 0; bj < 2; ++bj) {
            const int gidx = u.pn * 8 + bj * 4 + wc;
            if (gidx >= 37) continue;
#pragma unroll
            for (int ai = 0; ai < 2; ++ai)
#pragma unroll
                for (int m = 0; m < 4; ++m) {
                    const int row = u.pm * 256 + ai * 128 + wr * 64 + m * 16 + fr;
                    const bool meta = row >= MX; const int j = row - MX; const bool ok = !meta || j < NMETA;
                    const float rs_ = rt[u.ui * 256 + ai * 128 + wr * 64 + m * 16 + fr];
                    const f32x4 v0 = acc[ai][bj][m][0] * rs_, v1 = acc[ai][bj][m][1] * rs_;
                    if (gidx < 20) {
                        float ss = (v0[0] * v0[0] + v0[1] * v0[1]) + (v0[2] * v0[2] + v0[3] * v0[3]) + (v1[0] * v1[0] + v1[1] * v1[1]) + (v1[2] * v1[2] + v1[3] * v1[3]);
                        ss += __shfl_xor(ss, 16); ss += __shfl_xor(ss, 32);
                        if (ok) {
                            bf16_t* dst = CQ + (size_t)row * 768 + gidx * 32 + 8 * fq;
                            *(u32x4*)dst = pack8(v0, v1);
                            if (fq == 0) PART[(size_t)row * 20 + gidx] = ss;
                        }
                    } else if (gidx < 36) {
                        const int ch0 = (gidx - 20) * 32 + 8 * fq;
                        if (!meta) { const int g = ch0 >> 4, h0 = ch0 & 15, n = row >> 5, i = row & 31;
                            *(u32x4*)(UP + ((size_t)(g * NCH + n) * 768 + i * 16 + h0)) = pack8(v0, v1);
                        } else if (ok) { float* d = UM + j * 512 + ch0; *(f32x4*)d = v0; *(f32x4*)(d + 4) = v1; }
                    } else {
                        if (ok) {
                            const f32x4 cs = *(const f32x4*)(TAB + (size_t)row * 32 + 4 * fq), sn = *(const f32x4*)(TAB + (size_t)row * 32 + 16 + 4 * fq);
                            f32x4 o0, o1;
                            o0[0] = v0[0] * cs[0] - v0[1] * sn[0]; o0[1] = v0[0] * sn[0] + v0[1] * cs[0];
                            o0[2] = v0[2] * cs[1] - v0[3] * sn[1]; o0[3] = v0[2] * sn[1] + v0[3] * cs[1];
                            o1[0] = v1[0] * cs[2] - v1[1] * sn[2]; o1[1] = v1[0] * sn[2] + v1[1] * cs[2];
                            o1[2] = v1[2] * cs[3] - v1[3] * sn[3]; o1[3] = v1[2] * sn[3] + v1[3] * cs[3];
                            const u32x4 w = pack8(o0, o1);
                            if (!meta) *(u32x4*)(KR + (size_t)kvrow_of(row) * 32 + 8 * fq) = w;
                            else {
#pragma unroll
                                for (int b = 0; b < NB; ++b) *(u32x4*)(KR + (size_t)(b * KVR + SEQ + j) * 32 + 8 * fq) = w; }
                        }
                    }
                }
        }
    }
};
__device__ __forceinline__ float rstd_from(const float* p, int cnt4, float inv_n) {
    float s = 0.f;
    for (int i = 0; i < cnt4; ++i) { const f32x4 v = *(const f32x4*)(p + 4 * i); s += (v[0] + v[1]) + (v[2] + v[3]); }
    return __builtin_amdgcn_rsqf(s * inv_n + EPS);
}
struct EpiQ {
    static constexpr bool PERM = true, MID = false;
    bf16_t* Q; const LAS f32x2* tab; const float* TAB;
    __device__ __forceinline__ void operator()(const Acc& acc, const Unit& u, int wr, int wc, int fr, int fq) const {
        asm volatile("" : "+v"(fr), "+v"(fq));
#pragma unroll
        for (int ai = 0; ai < 2; ++ai)
#pragma unroll
            for (int m = 0; m < 4; ++m) {
                const int rl = ai * 128 + wr * 64 + m * 16 + fr, row = u.pm * 256 + rl;
                const float sc = tab[u.ui * 256 + rl][0];
#pragma unroll
                for (int bj = 0; bj < 2; ++bj) {
                    const int gidx = u.pn * 8 + bj * 4 + wc;
                    f32x4 v0 = acc[ai][bj][m][0] * sc, v1 = acc[ai][bj][m][1] * sc;
                    if (gidx % 3 == 2) {
                        const f32x4 cs = *(const f32x4*)(TAB + (size_t)row * 32 + 4 * fq), sn = *(const f32x4*)(TAB + (size_t)row * 32 + 16 + 4 * fq);
                        f32x4 o0, o1;
                        o0[0] = v0[0] * cs[0] - v0[1] * sn[0]; o0[1] = v0[0] * sn[0] + v0[1] * cs[0];
                        o0[2] = v0[2] * cs[1] - v0[3] * sn[1]; o0[3] = v0[2] * sn[1] + v0[3] * cs[1];
                        o1[0] = v1[0] * cs[2] - v1[1] * sn[2]; o1[1] = v1[0] * sn[2] + v1[1] * cs[2];
                        o1[2] = v1[2] * cs[3] - v1[3] * sn[3]; o1[3] = v1[2] * sn[3] + v1[3] * cs[3];
                        v0 = o0; v1 = o1;
                    }
                    *(u32x4*)(Q + (size_t)row * 768 + gidx * 32 + 8 * fq) = pack8(v0, v1);
                }
                asm volatile("" ::: "memory");
            }
    }
};
struct EpiKV {
    static constexpr bool PERM = true, MID = false;
    bf16_t *KN, *VV; const LAS f32x2* tab;
    __device__ __forceinline__ void operator()(const Acc& acc, const Unit& u, int wr, int wc, int fr, int fq) const {
        asm volatile("" : "+v"(fr), "+v"(fq));
#pragma unroll
        for (int ai = 0; ai < 2; ++ai)
#pragma unroll
            for (int m = 0; m < 4; ++m) {
                const int rl = ai * 128 + wr * 64 + m * 16 + fr, row = u.pm * 256 + rl;
                const bool meta = row >= MX; const int j = row - MX; if (meta && j >= NMETA) continue;
                const float sc = tab[u.ui * 256 + rl][0];
#pragma unroll
                for (int bj = 0; bj < 2; ++bj) {
                    const int gidx = u.pn * 8 + bj * 4 + wc;
                    const u32x4 w = pack8(acc[ai][bj][m][0] * sc, acc[ai][bj][m][1] * sc);
                    bf16_t* base = gidx < 16 ? KN : VV; const int col = (gidx & 15) * 32 + 8 * fq;
                    if (!meta) *(u32x4*)(base + (size_t)kvrow_of(row) * 512 + col) = w;
                    else {
#pragma unroll
                        for (int b = 0; b < NB; ++b) *(u32x4*)(base + (size_t)(b * KVR + SEQ + j) * 512 + col) = w; }
                }
                asm volatile("" ::: "memory");
            }
    }
};
struct EpiState {
    static constexpr bool PERM = true, MID = false;
    float* S;
    __device__ __forceinline__ void operator()(const Acc& acc, const Unit& u, int wr, int wc, int fr, int fq) const {
        asm volatile("" : "+v"(fr), "+v"(fq));
#pragma unroll
        for (int ai = 0; ai < 2; ++ai)
#pragma unroll
            for (int m = 0; m < 4; ++m) {
                const int row = u.pm * 256 + ai * 128 + wr * 64 + m * 16 + fr;
                float* d = S + ((size_t)u.pg * NCH + row) * 256 + wc * 32 + 8 * fq;
#pragma unroll
                for (int bj = 0; bj < 2; ++bj)
#pragma unroll
                    for (int n = 0; n < 2; ++n) *(f32x4*)(d + bj * 128 + n * 4) = acc[ai][bj][m][n];
            }
    }
};
__device__ __forceinline__ float gelu_tanh(float v) {
    const float t = v * (1.0f + 0.044715f * v * v) * (-2.0f * 0.7978845608028654f * 1.4426950408889634f);
    return v * __builtin_amdgcn_rcpf(1.0f + __builtin_amdgcn_exp2f(t));
}
struct EpiY {
    static constexpr bool PERM = true, MID = false;
    bf16_t* Y;
    __device__ __forceinline__ void operator()(const Acc& acc, const Unit& u, int wr, int wc, int fr, int fq) const {
        asm volatile("" : "+v"(fr), "+v"(fq));
#pragma unroll
        for (int ai = 0; ai < 2; ++ai)
#pragma unroll
            for (int m = 0; m < 4; ++m) {
                const int n = u.pm * 256 + ai * 128 + wr * 64 + m * 16 + fr;
#pragma unroll
                for (int bj = 0; bj < 2; ++bj) {
                    const int c = u.pn * 256 + bj * 128 + wc * 32 + 8 * fq, i = c >> 4, h0 = c & 15;
                    f32x4 v0 = acc[ai][bj][m][0], v1 = acc[ai][bj][m][1];
#pragma unroll
                    for (int e = 0; e < 4; ++e) { v0[e] = gelu_tanh(v0[e]); v1[e] = gelu_tanh(v1[e]); }
                    *(u32x4*)(Y + (size_t)(n * 32 + i) * 512 + u.pg * 16 + h0) = pack8(v0, v1);
                }
            }
    }
};
struct EpiGLU {
    static constexpr bool PERM = true, MID = false;
    bf16_t* MIX; float* PARTS;
    __device__ __forceinline__ void operator()(const Acc& acc, const Unit& u, int wr, int wc, int fr, int fq) const {
        asm volatile("" : "+v"(fr), "+v"(fq));
#pragma unroll
        for (int ai = 0; ai < 2; ++ai)
#pragma unroll
            for (int m = 0; m < 4; ++m) {
                const int row = u.pm * 256 + ai * 128 + wr * 64 + m * 16 + fr;
                f32x4 o[2]; float ss = 0.f;
#pragma unroll
                for (int n = 0; n < 2; ++n) { const f32x4 z1 = acc[ai][0][m][n], z2 = acc[ai][1][m][n];
#pragma unroll
                    for (int e = 0; e < 4; ++e) o[n][e] = z1[e] * __builtin_amdgcn_rcpf(1.0f + __builtin_amdgcn_exp2f(-1.4426950408889634f * z2[e]));
                    ss += (o[n][0] * o[n][0] + o[n][1] * o[n][1]) + (o[n][2] * o[n][2] + o[n][3] * o[n][3]); }
                ss += __shfl_xor(ss, 16); ss += __shfl_xor(ss, 32);
                *(u32x4*)(MIX + (size_t)row * 1024 + 512 + u.pn * 128 + wc * 32 + 8 * fq) = pack8(o[0], o[1]);
                if (fq == 0) PARTS[(size_t)row * 16 + u.pn * 4 + wc] = ss;
            }
    }
};
struct EpiWout {
    static constexpr bool PERM = false, MID = true;
    float* V1; const LAS f32x2* tab;
    __device__ __forceinline__ void mid(Acc& acc, const Unit& u, int wr, int wc, int fr, int fq) const {
        asm volatile("" : "+v"(fr), "+v"(fq));
#pragma unroll
        for (int ai = 0; ai < 2; ++ai)
#pragma unroll
            for (int m = 0; m < 4; ++m) {
                const int rl = ai * 128 + wr * 64 + m * 16 + fr;
                const float f = tab[u.ui * 256 + rl][0];
#pragma unroll
                for (int bj = 0; bj < 2; ++bj)
#pragma unroll
                    for (int n = 0; n < 2; ++n) acc[ai][bj][m][n] *= f;
                asm volatile("" ::: "memory");
            }
    }
    __device__ __forceinline__ void operator()(const Acc& acc, const Unit& u, int wr, int wc, int fr, int fq) const {
        asm volatile("" : "+v"(fr), "+v"(fq));
#pragma unroll
        for (int ai = 0; ai < 2; ++ai)
#pragma unroll
            for (int m = 0; m < 4; ++m) {
                const int rl = ai * 128 + wr * 64 + m * 16 + fr, row = u.pm * 256 + rl;
                const float rs = tab[u.ui * 256 + rl][1];
                float* d = V1 + (size_t)row * 1024 + u.pn * 256 + wc * 32 + 4 * fq;
#pragma unroll
                for (int bj = 0; bj < 2; ++bj)
#pragma unroll
                    for (int n = 0; n < 2; ++n) *(f32x4*)(d + bj * 128 + n * 16) = acc[ai][bj][m][n] * rs;
                asm volatile("" ::: "memory");
            }
    }
};
struct EpiRelu2 {
    static constexpr bool PERM = true, MID = false;
    bf16_t* H; const LAS float* tabf;
    __device__ __forceinline__ void operator()(const Acc& acc, const Unit& u, int wr, int wc, int fr, int fq) const {
        asm volatile("" : "+v"(fr), "+v"(fq));
#pragma unroll
        for (int ai = 0; ai < 2; ++ai)
#pragma unroll
            for (int m = 0; m < 4; ++m) {
                const int rl = ai * 128 + wr * 64 + m * 16 + fr, row = u.pm * 256 + rl;
                const float s2 = tabf[u.ui * 256 + rl];
#pragma unroll
                for (int bj = 0; bj < 2; ++bj) {
                    f32x4 v0 = acc[ai][bj][m][0], v1 = acc[ai][bj][m][1];
#pragma unroll
                    for (int e = 0; e < 4; ++e) { const float a = fmaxf(v0[e], 0.f), b = fmaxf(v1[e], 0.f); v0[e] = a * a * s2; v1[e] = b * b * s2; }
                    *(u32x4*)(H + (size_t)row * DFF + u.pn * 256 + bj * 128 + wc * 32 + 8 * fq) = pack8(v0, v1);
                }
            }
    }
};
struct EpiF32 {
    static constexpr bool PERM = false, MID = false;
    float* O;
    __device__ __forceinline__ void operator()(const Acc& acc, const Unit& u, int wr, int wc, int fr, int fq) const {
        asm volatile("" : "+v"(fr), "+v"(fq));
#pragma unroll
        for (int ai = 0; ai < 2; ++ai)
#pragma unroll
            for (int m = 0; m < 4; ++m) {
                const int row = u.pm * 256 + ai * 128 + wr * 64 + m * 16 + fr;
                float* d = O + (size_t)row * 1024 + u.pn * 256 + wc * 32 + 4 * fq;
#pragma unroll
                for (int bj = 0; bj < 2; ++bj)
#pragma unroll
                    for (int n = 0; n < 2; ++n) *(f32x4*)(d + bj * 128 + n * 16) = acc[ai][bj][m][n];
            }
    }
};

#define RLX_AGENT __ATOMIC_RELAXED, __HIP_MEMORY_SCOPE_AGENT
constexpr size_t WS_CNT = 128 * 1024;
constexpr size_t WS_XB = 456 * (size_t)(1u << 20);
struct PanelRms {
    float* xbuf; unsigned* cnt; unsigned* tmo;
    __device__ __forceinline__ void run(const Acc& v, const Unit& u, int wr, int wc, int fr, int fq, LAS unsigned char* tl) const {
        LAS float* P = (LAS float*)tl; LAS float* S = (LAS float*)(tl + 4096);
        const int wid = wr * 4 + wc, lane = fq * 16 + fr;
#pragma unroll
        for (int ai = 0; ai < 2; ++ai)
#pragma unroll
            for (int m = 0; m < 4; ++m) {
                float s = 0.f;
#pragma unroll
                for (int bj = 0; bj < 2; ++bj)
#pragma unroll
                    for (int n = 0; n < 2; ++n) { const f32x4 x = v[ai][bj][m][n]; s += (x[0] * x[0] + x[1] * x[1]) + (x[2] * x[2] + x[3] * x[3]); }
                s += __shfl_xor(s, 16); s += __shfl_xor(s, 32);
                if (fq == 0) P[(ai * 128 + wr * 64 + m * 16 + fr) * 4 + wc] = s;
            }
        asm volatile("s_waitcnt lgkmcnt(0)" ::: "memory"); __builtin_amdgcn_s_barrier(); asm volatile("" ::: "memory");
        const int row = wid * 32 + (lane & 31);
        if (lane < 32) {
            const float t = (P[row * 4 + 0] + P[row * 4 + 1]) + (P[row * 4 + 2] + P[row * 4 + 3]);
            __hip_atomic_store(xbuf + ((size_t)(u.pm * 256 + row) * 4 + u.pn), t, RLX_AGENT);
        }
        asm volatile("s_waitcnt vmcnt(0)" ::: "memory");
        if (lane == 0) __hip_atomic_fetch_add(cnt + 64 * u.pm, 1u, RLX_AGENT);
        if (wid == 0) {
            unsigned sp = 0;
            for (;;) {
                if ((unsigned)__builtin_amdgcn_readfirstlane(__hip_atomic_load(cnt + 64 * u.pm, RLX_AGENT)) >= 32u) break;
                if (++sp > (1u << 22)) { if (lane == 0) __hip_atomic_store(tmo, 1u, RLX_AGENT); break; }
                __builtin_amdgcn_s_sleep(1);
            }
        }
        asm volatile("s_waitcnt vmcnt(0) lgkmcnt(0)" ::: "memory"); __builtin_amdgcn_s_barrier(); asm volatile("" ::: "memory");
        if (lane < 32) {
            const float* slot = xbuf + (size_t)(u.pm * 256 + row) * 4; float t = 0.f;
#pragma unroll
            for (int k = 0; k < 4; ++k) t += __hip_atomic_load(slot + k, RLX_AGENT);
            S[row] = __builtin_amdgcn_rsqf(t * (1.0f / 1024.0f) + EPS);
        }
        asm volatile("s_waitcnt lgkmcnt(0)" ::: "memory"); __builtin_amdgcn_s_barrier(); asm volatile("" ::: "memory");
    }
};
struct EpiWoutLN {
    static constexpr bool PERM = true, MID = true;
    const bf16_t* xb; bf16_t* H1B; float* PARTH; const float* g1; const LAS f32x2* tab; LAS unsigned char* tl; PanelRms st1;
    __device__ __forceinline__ void mid(Acc& acc, const Unit& u, int wr, int wc, int fr, int fq) const {
        asm volatile("" : "+v"(fr), "+v"(fq));
#pragma unroll
        for (int ai = 0; ai < 2; ++ai)
#pragma unroll
            for (int m = 0; m < 4; ++m) {
                const int rl = ai * 128 + wr * 64 + m * 16 + fr;
                const float f = tab[u.ui * 256 + rl][0];
#pragma unroll
                for (int bj = 0; bj < 2; ++bj)
#pragma unroll
                    for (int n = 0; n < 2; ++n) acc[ai][bj][m][n] *= f;
            }
    }
    __device__ __forceinline__ void operator()(Acc& acc, const Unit& u, int wr, int wc, int fr, int fq) const {
        asm volatile("" : "+v"(fr), "+v"(fq));
        const LAS float* S = (const LAS float*)(tl + 4096);
#pragma unroll
        for (int ai = 0; ai < 2; ++ai)
#pragma unroll
            for (int m = 0; m < 4; ++m) { const float rs = tab[u.ui * 256 + ai * 128 + wr * 64 + m * 16 + fr][1];
#pragma unroll
                for (int bj = 0; bj < 2; ++bj)
#pragma unroll
                    for (int n = 0; n < 2; ++n) acc[ai][bj][m][n] *= rs; }
        const int col0 = u.pn * 256 + wc * 32 + 8 * fq;
        u32x4 xr_[2][4][2];
#define XR_LD(ai_, m_) do { const size_t off_ = (size_t)(u.pm * 256 + (ai_) * 128 + wr * 64 + (m_) * 16 + fr) * 1024 + col0; \
            xr_[ai_][m_][0] = *(const u32x4*)(xb + off_); xr_[ai_][m_][1] = *(const u32x4*)(xb + off_ + 128); } while (0)
        XR_LD(0, 0); XR_LD(0, 1); XR_LD(0, 2); XR_LD(0, 3); XR_LD(1, 0); XR_LD(1, 1);
        st1.run(acc, u, wr, wc, fr, fq, tl);
        XR_LD(1, 2); XR_LD(1, 3);
#undef XR_LD
#pragma unroll
        for (int ai = 0; ai < 2; ++ai) {
#pragma unroll
            for (int m = 0; m < 4; ++m) { const int rl = ai * 128 + wr * 64 + m * 16 + fr, row = u.pm * 256 + rl; const float r1 = S[rl]; const size_t off = (size_t)row * 1024 + col0;
#pragma unroll
                for (int bj = 0; bj < 2; ++bj) {
                    const f32x4 g0 = *(const f32x4*)(g1 + col0 + bj * 128), g4 = *(const f32x4*)(g1 + col0 + bj * 128 + 4);
                    const u32x4 xw = xr_[ai][m][bj]; f32x4 x0, x4;
                    x0[0] = __uint_as_float(xw.x << 16); x0[1] = __uint_as_float(xw.x & 0xffff0000u); x0[2] = __uint_as_float(xw.y << 16); x0[3] = __uint_as_float(xw.y & 0xffff0000u);
                    x4[0] = __uint_as_float(xw.z << 16); x4[1] = __uint_as_float(xw.z & 0xffff0000u); x4[2] = __uint_as_float(xw.w << 16); x4[3] = __uint_as_float(xw.w & 0xffff0000u);
                    const f32x4 h0 = x0 + acc[ai][bj][m][0] * r1 * g0, h4 = x4 + acc[ai][bj][m][1] * r1 * g4;
                    float ss = (h0[0] * h0[0] + h0[1] * h0[1]) + (h0[2] * h0[2] + h0[3] * h0[3]) + (h4[0] * h4[0] + h4[1] * h4[1]) + (h4[2] * h4[2] + h4[3] * h4[3]);
                    *(u32x4*)(H1B + off + bj * 128) = pack8(h0, h4);
                    ss += __shfl_xor(ss, 16); ss += __shfl_xor(ss, 32);
                    if (fq == 0) PARTH[(size_t)row * 32 + u.pn * 8 + bj * 4 + wc] = ss; }
                if (m & 1) asm volatile("" ::: "memory"); }
        }
    }
};
struct EpiDownLN {
    static constexpr bool PERM = true, MID = false;
    float* out; const bf16_t* H1B; const float* g; LAS unsigned char* tl; PanelRms st;
    __device__ __forceinline__ void operator()(Acc& acc, const Unit& u, int wr, int wc, int fr, int fq) const {
        asm volatile("" : "+v"(fr), "+v"(fq));
        const LAS float* S = (const LAS float*)(tl + 4096);
        const int col0 = u.pn * 256 + wc * 32 + 8 * fq;
        u32x4 pre[2][4][2];
#define HR_LD(ai_, m_) do { const size_t off_ = (size_t)(u.pm * 256 + (ai_) * 128 + wr * 64 + (m_) * 16 + fr) * 1024 + col0; \
            pre[ai_][m_][0] = *(const u32x4*)(H1B + off_); pre[ai_][m_][1] = *(const u32x4*)(H1B + off_ + 128); } while (0)
        HR_LD(0, 0); HR_LD(0, 1); HR_LD(0, 2); HR_LD(0, 3); HR_LD(1, 0); HR_LD(1, 1);
        st.run(acc, u, wr, wc, fr, fq, tl);
        HR_LD(1, 2); HR_LD(1, 3);
#undef HR_LD
#pragma unroll
        for (int ai = 0; ai < 2; ++ai) {
#pragma unroll
            for (int m = 0; m < 4; ++m) { const int rl = ai * 128 + wr * 64 + m * 16 + fr; const float r = S[rl]; const size_t off = (size_t)(u.pm * 256 + rl) * 1024 + col0;
#pragma unroll
                for (int bj = 0; bj < 2; ++bj) {
                    const f32x4 g0 = *(const f32x4*)(g + col0 + bj * 128), g4 = *(const f32x4*)(g + col0 + bj * 128 + 4);
                    const u32x4 hb = pre[ai][m][bj];
                    f32x4 h0, h4;
                    h0[0] = __uint_as_float(hb.x << 16); h0[1] = __uint_as_float(hb.x & 0xffff0000u); h0[2] = __uint_as_float(hb.y << 16); h0[3] = __uint_as_float(hb.y & 0xffff0000u);
                    h4[0] = __uint_as_float(hb.z << 16); h4[1] = __uint_as_float(hb.z & 0xffff0000u); h4[2] = __uint_as_float(hb.w << 16); h4[3] = __uint_as_float(hb.w & 0xffff0000u);
                    *(f32x4*)(out + off + bj * 128) = h0 + acc[ai][bj][m][0] * r * g0;
                    *(f32x4*)(out + off + bj * 128 + 4) = h4 + acc[ai][bj][m][1] * r * g4; }
                if (m & 1) asm volatile("" ::: "memory"); }
        }
    }
};

namespace attn {
constexpr int NW = 8, QBLK = 32, KVBLK = 64, NT = KVR / KVBLK;
constexpr int SHM_K = KVBLK * 96 * 2, SHM_V = KVBLK * 64 * 2;
constexpr int OFF_V = 0, OFF_K = 3 * SHM_V, OFF_WS = OFF_K + 3 * SHM_K, OFF_OST = OFF_WS + NW * 64 * 4, OST_WAVE = 32 * 272, LDS_END = OFF_OST + NW * OST_WAVE;
constexpr float THR = 11.5f;
#define SBAR() __builtin_amdgcn_sched_barrier(0)
__device__ __forceinline__ int crow(int r, int hi) { return (r & 3) + 8 * (r >> 2) + 4 * hi; }
template <bool FIRST> __device__ __forceinline__ void rowcheck(f32x16& p0, f32x16& p1, float& mhat, f32x16& negm, float& alpha) {
    float a = __builtin_fmaxf(__builtin_fmaxf(p0[0], p0[1]), p1[0]), b = __builtin_fmaxf(__builtin_fmaxf(p0[2], p0[3]), p1[1]); a = __builtin_fmaxf(__builtin_fmaxf(a, p1[2]), p1[3]);
#pragma unroll
    for (int r = 4; r < 16; r += 4) { a = __builtin_fmaxf(__builtin_fmaxf(a, p0[r]), p0[r + 1]); b = __builtin_fmaxf(__builtin_fmaxf(b, p0[r + 2]), p0[r + 3]);
        a = __builtin_fmaxf(__builtin_fmaxf(a, p1[r]), p1[r + 1]); b = __builtin_fmaxf(__builtin_fmaxf(b, p1[r + 2]), p1[r + 3]); }
    float rm = __builtin_fmaxf(a, b);
    { auto rr = __builtin_amdgcn_permlane32_swap(__float_as_uint(rm), __float_as_uint(rm), false, false); rm = __builtin_fmaxf(__uint_as_float(rr[0]), __uint_as_float(rr[1])); }
    alpha = 1.f;
    if (FIRST || __builtin_expect(__any(rm > THR), 0)) {
        const float dl = FIRST ? rm : __builtin_fmaxf(rm, 0.f); mhat += dl;
#pragma unroll
        for (int r = 0; r < 16; ++r) { p0[r] -= dl; p1[r] -= dl; }
#pragma unroll
        for (int r = 0; r < 16; ++r) negm[r] = -mhat;
        asm volatile("" : "+v"(negm));
        alpha = __builtin_amdgcn_exp2f(-dl);
    }
}
__device__ __forceinline__ void exp16(f32x16& p) {
#pragma unroll
    for (int r = 0; r < 16; ++r) p[r] = __builtin_amdgcn_exp2f(p[r]);
}
__device__ __forceinline__ void packP(const f32x16& p0, const f32x16& p1, bf16x8& pa0, bf16x8& pa1, bf16x8& pa2, bf16x8& pa3) {
#define PK4(P, BASE, OUT) do { u32x4 w = {cvt_pk_bf16(P[BASE + 0], P[BASE + 1]), cvt_pk_bf16(P[BASE + 2], P[BASE + 3]), cvt_pk_bf16(P[BASE + 4], P[BASE + 5]), cvt_pk_bf16(P[BASE + 6], P[BASE + 7])}; \
    OUT = *reinterpret_cast<bf16x8*>(&w); } while (0)
    PK4(p0, 0, pa0); PK4(p0, 8, pa1); PK4(p1, 0, pa2); PK4(p1, 8, pa3);
#undef PK4
}
__device__ __forceinline__ void qkt(f32x16& p0, f32x16& p1, const char* Ks, const int* kx, const bf16x8* qr, const f32x16& negm) {
#pragma unroll
    for (int d0 = 0; d0 < 6; ++d0) { const char* a = Ks + d0 * 2048 + kx[d0 & 3];
        const bf16x8 b0 = *reinterpret_cast<const bf16x8*>(a), b1 = *reinterpret_cast<const bf16x8*>(a + 512);
        if (d0 == 0) { p0 = __builtin_amdgcn_mfma_f32_32x32x16_bf16(b0, qr[0], negm, 0, 0, 0); p1 = __builtin_amdgcn_mfma_f32_32x32x16_bf16(b1, qr[0], negm, 0, 0, 0); }
        else { p0 = __builtin_amdgcn_mfma_f32_32x32x16_bf16(b0, qr[d0], p0, 0, 0, 0); p1 = __builtin_amdgcn_mfma_f32_32x32x16_bf16(b1, qr[d0], p1, 0, 0, 0); }
    }
}
__device__ __forceinline__ int v_st(int k, int c) { const int kk = (k & ~0xC) | ((k & 4) << 1) | ((k & 8) >> 1); return ((kk >> 3) * 2 + (c >> 5)) * 512 + ((kk & 7) * 32 + (c & 31)) * 2; }
__device__ __forceinline__ int v_rd_base(int lane) { return ((lane & 3) << 3) | (((lane >> 2) & 3) << 6) | (((lane >> 4) & 1) << 5) | (((lane >> 5) & 1) << 8); }
constexpr int v_rd_off(int d0, int ks, int half) { return d0 * 512 + ks * 2048 + half * 1024; }
template <int OFF> __device__ __forceinline__ s16x4 tr_read(int vb) {
    s16x4 r; asm volatile("ds_read_b64_tr_b16 %0, %1 offset:%2" : "=&v"(r) : "v"(vb), "i"(OFF) : "memory"); return r;
}
#define PKV(L, H) (bf16x8){L[0], L[1], L[2], L[3], H[0], H[1], H[2], H[3]}
template <int D0> __device__ __forceinline__ void pv_half(f32x16& od, int vb, bf16x8 pa0, bf16x8 pa1, bf16x8 pa2, bf16x8 pa3) {
    const s16x4 a0 = tr_read<v_rd_off(D0, 0, 0)>(vb), b0 = tr_read<v_rd_off(D0, 0, 1)>(vb), a1 = tr_read<v_rd_off(D0, 1, 0)>(vb), b1 = tr_read<v_rd_off(D0, 1, 1)>(vb);
    const s16x4 a2 = tr_read<v_rd_off(D0, 2, 0)>(vb), b2 = tr_read<v_rd_off(D0, 2, 1)>(vb), a3 = tr_read<v_rd_off(D0, 3, 0)>(vb), b3 = tr_read<v_rd_off(D0, 3, 1)>(vb);
    asm volatile("s_waitcnt lgkmcnt(0)" ::: "memory"); SBAR();
    od = __builtin_amdgcn_mfma_f32_32x32x16_bf16(pa0, PKV(a0, b0), od, 0, 0, 0);
    od = __builtin_amdgcn_mfma_f32_32x32x16_bf16(pa1, PKV(a1, b1), od, 0, 0, 0);
    od = __builtin_amdgcn_mfma_f32_32x32x16_bf16(pa2, PKV(a2, b2), od, 0, 0, 0);
    od = __builtin_amdgcn_mfma_f32_32x32x16_bf16(pa3, PKV(a3, b3), od, 0, 0, 0);
}
__device__ __forceinline__ void pv_all(f32x16* o, f32x4& osum, bf16x8 ones, int vb, bf16x8 pa0, bf16x8 pa1, bf16x8 pa2, bf16x8 pa3) {
    osum = __builtin_amdgcn_mfma_f32_16x16x32_bf16(pa0, ones, osum, 0, 0, 0); osum = __builtin_amdgcn_mfma_f32_16x16x32_bf16(pa1, ones, osum, 0, 0, 0);
    osum = __builtin_amdgcn_mfma_f32_16x16x32_bf16(pa2, ones, osum, 0, 0, 0); osum = __builtin_amdgcn_mfma_f32_16x16x32_bf16(pa3, ones, osum, 0, 0, 0);
    pv_half<0>(o[0], vb, pa0, pa1, pa2, pa3); pv_half<1>(o[1], vb, pa0, pa1, pa2, pa3);
}
typedef short v4i16_t __attribute__((ext_vector_type(4)));
__device__ __forceinline__ s16x4 vtr(const LAS char* p) { return __builtin_bit_cast(s16x4, __builtin_amdgcn_ds_read_tr16_b64_v4i16((LAS v4i16_t*)p)); }
template <bool EXACT> __device__ __forceinline__ bool attn_unit(int b, int h, int qb, const bf16_t* __restrict__ Q, const bf16_t* __restrict__ KN, const bf16_t* __restrict__ KRp, const bf16_t* __restrict__ VV,
                                          bf16_t* MIX, float* PARTA, char* lds, const LAS char* lds3, const int wid) {
    int tid = tid_of(wid); asm volatile("" : "+v"(tid));
    const int lane = tid & 63, r32 = lane & 31, hi = lane >> 5;
    char* V_lds = lds + OFF_V; char* K_lds = lds + OFF_K;
    float* ws = (float*)(lds + OFF_WS) + wid * 64; float* al_l = ws + 32;
    float mhat = 0.f; f32x16 o[2] = {}; f32x4 osum = {}; f32x16 negm = {}; if (EXACT) asm volatile("" : "+v"(negm)); const f32x16 zero16 = {}; bf16x8 qr[6];
    const int lrow0 = (lane >> 4) * 4 + ((lane >> 3) & 1) * 16;
    bf16x8 ones; { const unsigned o1 = (((lane >> 4) ^ (lane >> 3)) & 1) ? 0u : 0x3F803F80u; const u32x4 w1 = {o1, o1, o1, o1}; ones = *reinterpret_cast<const bf16x8*>(&w1); asm volatile("" : "+v"(ones)); }
    const int xr0 = b * SEQ + qb * 256 + wid * QBLK;
    const bf16_t* Qw = Q + (size_t)(xr0 + r32) * 768 + h * 96 + hi * 8;
#pragma unroll
    for (int d0 = 0; d0 < 6; ++d0) qr[d0] = *reinterpret_cast<const bf16x8*>(Qw + d0 * 16);
    const size_t kvb = (size_t)b * KVR;
    const bf16_t* kn_src = KN + (kvb + (lane ^ wid)) * 512 + h * 64 + wid * 8;
    const int vkk = 8 * wid + ((lane & 31) >> 2), vkey = (vkk & ~0xC) | ((vkk & 4) << 1) | ((vkk & 8) >> 1);
    const bf16_t* vv_src = VV + (kvb + vkey) * 512 + h * 64 + (lane >> 5) * 32 + (lane & 3) * 8;
    const bf16_t* kr_src = KRp + (kvb + (lane ^ (wid & 3))) * 32 + (wid & 3) * 8;
    const int krow = (r32 & ~0xC) | ((r32 & 4) << 1) | ((r32 & 8) >> 1);
    const int kbase = hi * 1024 + ((krow ^ hi) << 4);
    int kx[4];
#pragma unroll
    for (int i = 0; i < 4; ++i) kx[i] = kbase ^ (i << 5);
    const int vb0 = (int)(uintptr_t)V_lds + v_rd_base(lane);
    const LAS char* vp0 = lds3 + OFF_V + v_rd_base(lane);
    const LAS char* kp0 = lds3 + OFF_K;
    const bool do_rope = wid < 4;
#define DMA16(gp, lp) __builtin_amdgcn_global_load_lds((const unsigned*)(gp), (LAS unsigned*)(lp), 16, 0, 0)
#define SDMA_K(slot, t) DMA16(kn_src + (size_t)(t) * KVBLK * 512, lds3 + OFF_K + (slot) * SHM_K + wid * 1024)
#define SDMA_V(slot, t) DMA16(vv_src + (size_t)(t) * KVBLK * 512, lds3 + OFF_V + (slot) * SHM_V + wid * 1024)
#define SDMA_R(slot, t) do { if (do_rope) DMA16(kr_src + (size_t)(t) * KVBLK * 32, lds3 + OFF_K + (slot) * SHM_K + (8 + wid) * 1024); } while (0)
#define SDMA(slot, t) do { SDMA_K(slot, t); SDMA_V(slot, t); SDMA_R(slot, t); } while (0)
#define DMA_SYNC() do { asm volatile("s_waitcnt vmcnt(0)" ::: "memory"); __syncthreads(); } while (0)
#define RESC(a) do { if (__any((a) < 1.f)) { if (hi == 0) al_l[r32] = (a); asm volatile("s_waitcnt lgkmcnt(0)" ::: "memory"); \
    _Pragma("unroll") for (int r = 0; r < 16; ++r) { const float f_ = al_l[crow(r, hi)]; o[0][r] *= f_; o[1][r] *= f_; } \
    _Pragma("unroll") for (int r = 0; r < 4; ++r) osum[r] *= al_l[lrow0 + r]; } } while (0)
    f32x16 pA0, pA1, pB0, pB1; float alA, alB; bf16x8 pa0, pa1, pa2, pa3;
    int s_prev = 0, s_cur = 0, s_next = 1;
#define ROT() do { s_prev = s_cur; s_cur = s_next; s_next = (s_next == 2) ? 0 : s_next + 1; } while (0)
    SDMA(0, 0); SDMA(1, 1);
    DMA_SYNC();
    qkt(pA0, pA1, K_lds, kx, qr, negm); if (EXACT) rowcheck<true>(pA0, pA1, mhat, negm, alA);
    exp16(pA0); if (!EXACT) exp16(pA1);
    ROT();
#define MF(A_, B_, C_) __builtin_amdgcn_mfma_f32_32x32x16_bf16(A_, B_, C_, 0, 0, 0)
#define MFS(A_, B_, C_) __builtin_amdgcn_mfma_f32_16x16x32_bf16(A_, B_, C_, 0, 0, 0)
#define EX2(P, i) do { P[i] = __builtin_amdgcn_exp2f(P[i]); P[(i) + 1] = __builtin_amdgcn_exp2f(P[(i) + 1]); asm volatile("" : "+v"(P)); } while (0)
#define KF(d0, half) (*(const LAS bf16x8*)(kp_ + (d0) * 2048 + kx[(d0) & 3] + (half) * 512))
#define VR(d0, ks, half) vtr(vp_ + v_rd_off(d0, ks, half))
#define MX3(a, b, c) __builtin_fmaxf(__builtin_fmaxf((a), (b)), (c))
#define EX1(P, i) do { P[i] = __builtin_amdgcn_exp2f(P[i]); asm volatile("" : "+v"(P)); } while (0)
#define PERMW(OUT) do { u32x4 w_ = {ua0, ua1, ub0, ub1}; OUT = *reinterpret_cast<bf16x8*>(&w_); } while (0)
#define STEP(C0, C1, ALC, P0, P1, t, MASKED) do { \
    const LAS char* kp_ = kp0 + s_cur * SHM_K; const LAS char* vp_ = vp0 + s_prev * SHM_V; \
    unsigned ua0, ua1, ub0, ub1; \
    bf16x8 ka0 = KF(0, 0), kb0 = KF(0, 1), ka1 = KF(1, 0), kb1 = KF(1, 1); \
    SBAR(); \
    if ((t) + 1 < NT) SDMA(s_next, (t) + 1);        \
    SBAR(); \
    C0 = MF(ka0, qr[0], (EXACT ? negm : zero16)); if (EXACT) EX2(P1, 0); ua0 = cvt_pk_bf16(P0[0], P0[1]); ua1 = cvt_pk_bf16(P0[2], P0[3]); SBAR(); \
    C1 = MF(kb0, qr[0], (EXACT ? negm : zero16)); if (EXACT) EX2(P1, 2); ub0 = cvt_pk_bf16(P0[4], P0[5]); ub1 = cvt_pk_bf16(P0[6], P0[7]); ka0 = KF(2, 0); kb0 = KF(2, 1); SBAR(); \
    C0 = MF(ka1, qr[1], C0); if (EXACT) EX2(P1, 4); PERMW(pa0); SBAR(); \
    C1 = MF(kb1, qr[1], C1); if (EXACT) EX2(P1, 6); ua0 = cvt_pk_bf16(P0[8], P0[9]); ua1 = cvt_pk_bf16(P0[10], P0[11]); SBAR(); \
    C0 = MF(ka0, qr[2], C0); if (EXACT) EX2(P1, 8); ub0 = cvt_pk_bf16(P0[12], P0[13]); ub1 = cvt_pk_bf16(P0[14], P0[15]); ka1 = KF(3, 0); kb1 = KF(3, 1); SBAR(); \
    C1 = MF(kb0, qr[2], C1); if (EXACT) EX2(P1, 10); PERMW(pa1); SBAR(); \
    C0 = MF(ka1, qr[3], C0); if (EXACT) EX2(P1, 12); ua0 = cvt_pk_bf16(P1[0], P1[1]); ua1 = cvt_pk_bf16(P1[2], P1[3]); ka0 = KF(4, 0); kb0 = KF(4, 1); SBAR(); \
    C1 = MF(kb1, qr[3], C1); if (EXACT) EX2(P1, 14); ub0 = cvt_pk_bf16(P1[4], P1[5]); ub1 = cvt_pk_bf16(P1[6], P1[7]); SBAR(); \
    C0 = MF(ka0, qr[4], C0); PERMW(pa2); ua0 = cvt_pk_bf16(P1[8], P1[9]); ka1 = KF(5, 0); kb1 = KF(5, 1); SBAR(); \
    C1 = MF(kb0, qr[4], C1); ua1 = cvt_pk_bf16(P1[10], P1[11]); ub0 = cvt_pk_bf16(P1[12], P1[13]); SBAR(); \
    C0 = MF(ka1, qr[5], C0); ub1 = cvt_pk_bf16(P1[14], P1[15]); SBAR(); \
    C1 = MF(kb1, qr[5], C1); PERMW(pa3); SBAR(); \
    if (MASKED) { _Pragma("unroll") for (int r = 8; r < 16; ++r) C0[r] = -INFINITY; _Pragma("unroll") for (int r = 0; r < 16; ++r) C1[r] = -INFINITY; } \
    s16x4 v00 = VR(0, 0, 0), v01 = VR(0, 0, 1), v10 = VR(1, 0, 0), v11 = VR(1, 0, 1); float ma_ = 0.f, mb_ = 0.f; (void)ma_; (void)mb_; \
    SBAR(); \
    osum = MFS(pa0, ones, osum); if (!EXACT) { EX2(C0, 0); EX1(C0, 2); } if (EXACT) { ma_ = MX3(C0[0], C0[1], C1[0]); mb_ = MX3(C0[2], C0[3], C1[1]); ma_ = MX3(ma_, C1[2], C1[3]); mb_ = MX3(mb_, C0[4], C0[5]); } SBAR(); \
    osum = MFS(pa1, ones, osum); if (!EXACT) { EX1(C0, 3); EX2(C0, 4); } if (EXACT) { ma_ = MX3(ma_, C0[6], C0[7]); mb_ = MX3(mb_, C1[4], C1[5]); ma_ = MX3(ma_, C1[6], C1[7]); mb_ = MX3(mb_, C0[8], C0[9]); } SBAR(); \
    osum = MFS(pa2, ones, osum); if (!EXACT) { EX2(C0, 6); } if (EXACT) { ma_ = MX3(ma_, C0[10], C0[11]); mb_ = MX3(mb_, C1[8], C1[9]); ma_ = MX3(ma_, C1[10], C1[11]); mb_ = MX3(mb_, C0[12], C0[13]); } SBAR(); \
    osum = MFS(pa3, ones, osum); ALC = 1.f; if (!EXACT) { EX2(C0, 8); EX1(C0, 10); } \
    if (EXACT) { ma_ = MX3(ma_, C0[14], C0[15]); mb_ = MX3(mb_, C1[12], C1[13]); ma_ = MX3(ma_, C1[14], C1[15]); \
      float rm_ = __builtin_fmaxf(ma_, mb_); auto rr_ = __builtin_amdgcn_permlane32_swap(__float_as_uint(rm_), __float_as_uint(rm_), false, false); rm_ = __builtin_fmaxf(__uint_as_float(rr_[0]), __uint_as_float(rr_[1])); \
      if (__builtin_expect(__any(rm_ > THR), 0)) { const float dl_ = __builtin_fmaxf(rm_, 0.f); mhat += dl_; \
        _Pragma("unroll") for (int r = 0; r < 16; ++r) { C0[r] -= dl_; C1[r] -= dl_; } \
        _Pragma("unroll") for (int r = 0; r < 16; ++r) negm[r] = -mhat; asm volatile("" : "+v"(negm)); \
        ALC = __builtin_amdgcn_exp2f(-dl_); } } \
    SBAR(); \
    o[0] = MF(pa0, PKV(v00, v01), o[0]); if (EXACT) EX2(C0, 0); else { EX1(C0, 11); EX2(C0, 12); } s16x4 w00 = VR(0, 1, 0), w01 = VR(0, 1, 1), w10 = VR(1, 1, 0), w11 = VR(1, 1, 1); SBAR(); \
    o[1] = MF(pa0, PKV(v10, v11), o[1]); if (EXACT) EX2(C0, 2); else { EX2(C0, 14); } SBAR(); \
    o[0] = MF(pa1, PKV(w00, w01), o[0]); if (EXACT) EX2(C0, 4); else { EX2(C1, 0); EX1(C1, 2); } v00 = VR(0, 2, 0); v01 = VR(0, 2, 1); v10 = VR(1, 2, 0); v11 = VR(1, 2, 1); SBAR(); \
    o[1] = MF(pa1, PKV(w10, w11), o[1]); if (EXACT) EX2(C0, 6); else { EX1(C1, 3); EX2(C1, 4); } SBAR(); \
    o[0] = MF(pa2, PKV(v00, v01), o[0]); if (EXACT) EX2(C0, 8); else { EX2(C1, 6); } w00 = VR(0, 3, 0); w01 = VR(0, 3, 1); w10 = VR(1, 3, 0); w11 = VR(1, 3, 1); SBAR(); \
    o[1] = MF(pa2, PKV(v10, v11), o[1]); if (EXACT) EX2(C0, 10); else { EX2(C1, 8); EX1(C1, 10); } SBAR(); \
    o[0] = MF(pa3, PKV(w00, w01), o[0]); if (EXACT) EX2(C0, 12); else { EX1(C1, 11); EX2(C1, 12); } SBAR(); \
    o[1] = MF(pa3, PKV(w10, w11), o[1]); if (EXACT) EX2(C0, 14); else { EX2(C1, 14); } SBAR(); \
    if (EXACT) RESC(ALC); \
    DMA_SYNC(); ROT(); } while (0)
    for (int j = 1; j < NT - 2; j += 2) {
        STEP(pB0, pB1, alB, pA0, pA1, j, false);
        STEP(pA0, pA1, alA, pB0, pB1, j + 1, false);
    }
    STEP(pB0, pB1, alB, pA0, pA1, NT - 2, false);
    STEP(pA0, pA1, alA, pB0, pB1, NT - 1, true);
    if (EXACT) exp16(pA1);
    packP(pA0, pA1, pa0, pa1, pa2, pa3); SBAR();
    pv_all(o, osum, ones, vb0 + s_prev * SHM_V, pa0, pa1, pa2, pa3);
    bool ok = true;
    if (!EXACT) {
        float lo = osum[0], hi_ = osum[0], om = 0.f;
#pragma unroll
        for (int r = 1; r < 4; ++r) { lo = __builtin_fminf(lo, osum[r]); hi_ = __builtin_fmaxf(hi_, osum[r]); }
#pragma unroll
        for (int r = 0; r < 16; ++r) om = __builtin_fmaxf(om, __builtin_fmaxf(__builtin_fabsf(o[0][r]), __builtin_fabsf(o[1][r])));
        bool good = (lo > 0.f) && (hi_ < 1e37f) && (om < 1e37f);
#pragma unroll
        for (int r = 0; r < 16; ++r) good = good && (osum[r & 3] == osum[r & 3]) && (o[0][r] == o[0][r]) && (o[1][r] == o[1][r]);
        LAS unsigned* okf = (LAS unsigned*)(lds3 + OFF_WS);
        if (lane == 0) okf[wid * 64] = __all(good) ? 1u : 0u;
        __syncthreads();
        unsigned all_ok = 1u;
#pragma unroll
        for (int w = 0; w < NW; ++w) all_ok &= okf[w * 64];
        ok = all_ok != 0u;
        __syncthreads();
        if (!ok) return false;
    }
    float rli[16];
    if ((lane & 7) == 0) {
#pragma unroll
        for (int r = 0; r < 4; ++r) ws[lrow0 + r] = osum[r]; }
    asm volatile("s_waitcnt lgkmcnt(0)" ::: "memory");
#pragma unroll
    for (int r = 0; r < 16; ++r) rli[r] = __builtin_amdgcn_rcpf(ws[crow(r, hi)]);
    float* stg = (float*)(lds + OFF_OST + wid * OST_WAVE);
#pragma unroll
    for (int r = 0; r < 16; ++r) { const int orow = crow(r, hi);
#pragma unroll
        for (int d0 = 0; d0 < 2; ++d0) stg[orow * 68 + d0 * 32 + r32] = o[d0][r] * rli[r]; }
    asm volatile("s_waitcnt lgkmcnt(0)" ::: "memory");
    { const int row = lane >> 1, half = lane & 1; const float* s = stg + row * 68 + half * 32; f32x4 v[8]; float ss = 0.f;
#pragma unroll
      for (int i = 0; i < 8; ++i) { v[i] = *(const f32x4*)(s + 4 * i); ss += (v[i][0] * v[i][0] + v[i][1] * v[i][1]) + (v[i][2] * v[i][2] + v[i][3] * v[i][3]); }
      ss += __shfl_xor(ss, 1);
      bf16_t* dst = MIX + (size_t)(xr0 + row) * 1024 + h * 64 + half * 32;
#pragma unroll
      for (int i = 0; i < 4; ++i) *(u32x4*)(dst + 8 * i) = pack8(v[2 * i], v[2 * i + 1]);
      if (half == 0) PARTA[(size_t)(xr0 + row) * 8 + h] = ss; }
    __syncthreads();
    return ok;
#undef SDMA
#undef SDMA_K
#undef SDMA_V
#undef SDMA_R
#undef DMA16
#undef DMA_SYNC
#undef RESC
#undef ROT
#undef STEP
#undef PKV
#undef MF
#undef MFS
#undef EX2
#undef KF
#undef VR
#undef MX3
#undef EX1
#undef PERMW
}
#undef SBAR
static_assert(LDS_END <= LDS_BYTES - 64, "attention LDS");
}

template <int MID> __device__ __forceinline__ int srccol(int n) {
    if (MID == 0) { if (n < 640) return n; if (n < 1152) return n + 32; if (n < 1184) { const int t = n - 1152; return 640 + ((t & 1) ? 16 + (t >> 1) : (t >> 1)); } return -1; }
    if (MID == 1) { const int h = n / 96, t = n % 96; if (t < 64) return n; const int tt = t - 64; return h * 96 + 64 + ((tt & 1) ? 16 + (tt >> 1) : (tt >> 1)); }
    if (MID == 2) { if (n < 512) return (n >> 6) * 128 + (n & 63); const int mm = n - 512; return (mm >> 6) * 128 + 64 + (mm & 63); }
    if (MID == 3) { const int tile = n >> 8, c = n & 255; return c < 128 ? 128 * tile + c : 512 + 128 * tile + (c - 128); }
    return n;
}
template <int MID> __device__ __forceinline__ void transpose_item(const float* W, int K, int N, int Nsrc, const float* kscale, bf16_t* WT, LAS float* scr, int item, int lane, int ldw = 0) {
    if (ldw == 0) ldw = K;
    const int nblk = N / 32, kb = item / nblk, nb = item % nblk, k0 = 64 * kb, n0 = 32 * nb;
    const int src = srccol<MID>(n0 + (lane & 31));
    float tv[32];
#pragma unroll
    for (int i = 0; i < 32; ++i) { const int kk = 2 * i + (lane >> 5); tv[i] = src >= 0 ? __builtin_nontemporal_load(W + (size_t)(k0 + kk) * Nsrc + src) : 0.f; }
#pragma unroll
    for (int i = 0; i < 32; ++i) { const int kk = 2 * i + (lane >> 5); float v = tv[i]; if (kscale) v *= kscale[k0 + kk]; scr[kk * 33 + (lane & 31)] = v; }
    LDS_WAIT(); asm volatile("" ::: "memory");
    const int c = lane & 7;
#pragma unroll
    for (int j = 0; j < 4; ++j) { const int n = (lane >> 3) + 8 * j; const LAS float* s = scr + (8 * c) * 33 + n;
        u32x4 o; o.x = cvt_pk_bf16(s[0 * 33], s[1 * 33]); o.y = cvt_pk_bf16(s[2 * 33], s[3 * 33]); o.z = cvt_pk_bf16(s[4 * 33], s[5 * 33]); o.w = cvt_pk_bf16(s[6 * 33], s[7 * 33]);
        *(u32x4*)(WT + (size_t)(n0 + n) * ldw + k0 + 8 * c) = o; }
    LDS_WAIT(); asm volatile("" ::: "memory");
}
__device__ __forceinline__ void lam_pow(float lr, float li, float dt, float k, float& re, float& im) {
    const float mag = __expf(lr * dt * k);
    double t = (double)li * (double)dt * (double)k * 0.15915494309189535; t -= __builtin_rint(t);
    const float f = (float)t;
    re = mag * __builtin_amdgcn_cosf(f); im = mag * __builtin_amdgcn_sinf(f);
}
struct SsmP { float lr, li, dt, qr, qi; };
__device__ __forceinline__ SsmP ssm_params(const float* A_re, const float* A_im, const float* log_dt, int dir, int g, int p) {
    SsmP s; s.lr = fminf(A_re[(dir * 32 + g) * 64 + p], -1e-4f); s.li = A_im[(dir * 32 + g) * 64 + p]; s.dt = __expf(log_dt[dir * 32 + g]);
    float br, bi; lam_pow(s.lr, s.li, s.dt, 1.f, br, bi);
    const float nr = br - 1.f, ni = bi, den = 1.0f / (s.lr * s.lr + s.li * s.li);
    s.qr = (nr * s.lr + ni * s.li) * den; s.qi = (ni * s.lr - nr * s.li) * den; return s;
}


#define XB_TMO      128
#define XB_XCNT(j)  (256  + 64 * (j))
#define XB_XSUB(j)  (1280 + 64 * (j))
#define XB_XGEN(j)  (2304 + 64 * (j))
#define XB_TOP      3328
#define XB_TOPGEN   3392
#define XCD_BAR_WORDS 3456
#define XB_SPIN_CAP (1u << 22)
constexpr size_t WS_BAR = 65536;
__device__ __forceinline__ unsigned xb_ld(unsigned* p)              { return __hip_atomic_load(p, __ATOMIC_RELAXED, __HIP_MEMORY_SCOPE_AGENT); }
__device__ __forceinline__ unsigned xb_add(unsigned* p, unsigned v) { return __hip_atomic_fetch_add(p, v, __ATOMIC_RELAXED, __HIP_MEMORY_SCOPE_AGENT); }
__device__ __forceinline__ unsigned xb_xcc_id() { return (unsigned)__builtin_amdgcn_s_getreg((3 << 11) | 20) & 0xFu; }
#define XB_SPIN(cond, bar) do { unsigned _sp = 0; while (cond) { __builtin_amdgcn_s_sleep(1); \
    if ((++_sp & 255u) == 0u) { if (xb_ld(&(bar)[XB_TMO])) break; if (_sp > XB_SPIN_CAP) { atomicAdd(&(bar)[XB_TMO], 1u); break; } } } } while (0)
struct XcdBarrier { unsigned* bar; unsigned x; volatile LAS unsigned* st; };
__device__ __forceinline__ XcdBarrier xcd_barrier_post(unsigned* bar, volatile LAS unsigned* st) {
    XcdBarrier b; b.bar = bar; b.x = xb_xcc_id(); b.st = st;
    if (threadIdx.x == 0) (void)xb_add(&bar[XB_XCNT(b.x)], 1u);
    return b;
}
__device__ __forceinline__ void xcd_barrier_complete(unsigned* bar, unsigned x, unsigned& nloc, unsigned& nx) {
    const unsigned G = gridDim.x * gridDim.y * gridDim.z;
    unsigned sum, cnt, mine, sp = 0u;
    for (;;) {
        sum = 0u; cnt = 0u; mine = 0u;
#pragma unroll
        for (unsigned j = 0; j < 16; ++j) { const unsigned c = xb_ld(&bar[XB_XCNT(j)]); sum += c; cnt += (c > 0u) ? 1u : 0u; mine = (j == x) ? c : mine; }
        if (sum == G) break;
        __builtin_amdgcn_s_sleep(1);
        if ((++sp & 255u) == 0u) { if (xb_ld(&bar[XB_TMO])) break; if (sp > XB_SPIN_CAP) { atomicAdd(&bar[XB_TMO], 1u); break; } }
    }
    nloc = mine > 0u ? mine : 1u; nx = cnt > 0u ? cnt : 1u;
}
__device__ __forceinline__ void xcd_barrier(const XcdBarrier& b) {
    asm volatile("s_waitcnt vmcnt(0)" ::: "memory");
    __syncthreads();
    if (threadIdx.x == 0) {
        unsigned* bar = b.bar;
        __builtin_amdgcn_s_waitcnt(0);
        unsigned nloc = b.st[0], nx = b.st[1];
        if (nloc == 0u) { xcd_barrier_complete(bar, b.x, nloc, nx); b.st[0] = nloc; b.st[1] = nx; }
        const unsigned old = xb_add(&bar[XB_XSUB(b.x)], 1u);
        const unsigned gen = old / nloc;
        if (old + 1u == (gen + 1u) * nloc) {
            __builtin_amdgcn_fence(__ATOMIC_RELEASE, "agent");
            asm volatile("s_waitcnt vmcnt(0)" ::: "memory");
            const unsigned og = xb_add(&bar[XB_TOP], 1u);
            const unsigned tg = og / nx;
            if (og + 1u == (tg + 1u) * nx) xb_add(&bar[XB_TOPGEN], 1u);
            else XB_SPIN(xb_ld(&bar[XB_TOPGEN]) == tg, bar);
            xb_add(&bar[XB_XGEN(b.x)], 1u);
            __builtin_amdgcn_fence(__ATOMIC_ACQUIRE, "agent");
            asm volatile("s_waitcnt vmcnt(0)" ::: "memory");
        } else {
            XB_SPIN(xb_ld(&bar[XB_XGEN(b.x)]) == gen, bar);
            __builtin_amdgcn_fence(__ATOMIC_ACQUIRE, "agent");
            asm volatile("s_waitcnt vmcnt(0)" ::: "memory");
        }
    }
    __syncthreads();
}

#define XL_FLAG     3520
#define XL_ID       3584
#define XL_CNT(g, k) (4096 + 64 * ((g) * 4 + (k)))
__device__ __forceinline__ void xl_barrier(unsigned* bar, unsigned* cnt, unsigned members) {
    asm volatile("s_waitcnt vmcnt(0)" ::: "memory");
    __syncthreads();
    if (threadIdx.x == 0) {
        (void)xb_add(cnt, 1u);
        XB_SPIN(xb_ld(cnt) < members, bar);
        __builtin_amdgcn_fence(__ATOMIC_ACQUIRE, "agent");
        asm volatile("s_waitcnt vmcnt(0)" ::: "memory");
    }
    __syncthreads();
}

struct Args {
    const float *x, *meta, *g_pre_mix, *w_in, *g_q_lat, *w_uq, *g_kv_lat, *w_ukv, *A_re, *A_im, *log_dt, *B_re, *B_im, *C_re, *C_im, *Dv, *w_glu, *g_mix_out, *w_out, *g_post_mix, *g_pre_mlp, *w_up, *w_down, *g_post_mlp;
    const int* positions; float* out; unsigned char* ws;
};

__global__ void __launch_bounds__(NTHR, 2) fwd_megakernel(Args a) {
    extern __shared__ __attribute__((aligned(16))) unsigned char lds_raw[];
    cg::grid_group grid = cg::this_grid();
    LAS unsigned char* lds = (LAS unsigned char*)lds_raw;
    const int wave = __builtin_amdgcn_readfirstlane(threadIdx.x >> 6);
    const int G = gridDim.x, bid = blockIdx.x;
    const int gw = bid * NWAVES + wave, NGW = G * NWAVES, NGT = G * NTHR;
#define TID_FRESH() const int tid = tid_of(wave), lane = tid & 63, gt = bid * NTHR + tid; (void)lane; (void)gt
    typedef const __attribute__((address_space(4))) Args* ArgP;
    const ArgP ap0 = (ArgP)__builtin_amdgcn_kernarg_segment_ptr();
#define ARGS_FRESH() ArgP ap = ap0; asm volatile("" : "+s"(ap))
    unsigned char* ws = ap0->ws;
#define STAMP(k) do { if (PROBE_A >= 0 && blockIdx.x == 0 && tid_of(wave) == 0) ((unsigned long long*)ws)[k] = __builtin_amdgcn_s_memrealtime(); } while (0)
    STAMP(0);
    { volatile LAS unsigned* st0 = (volatile LAS unsigned*)(lds + XBST_OFF); if (threadIdx.x == 0) { st0[0] = 0u; st0[1] = 0u; } __syncthreads(); }
    (void)xcd_barrier_post((unsigned*)(ws + WS_BAR), (volatile LAS unsigned*)(lds + XBST_OFF));
    const unsigned my_xcc = xb_xcc_id() + 1u;
    if (threadIdx.x == 0) __hip_atomic_store((unsigned*)(ws + WS_BAR) + XL_ID + bid, my_xcc, RLX_AGENT);
#define XBAR() do { XcdBarrier xb_; xb_.bar = (unsigned*)(ws + WS_BAR); xb_.x = xb_xcc_id(); xb_.st = (volatile LAS unsigned*)(lds + XBST_OFF); xcd_barrier(xb_); } while (0)
#define P_Win ((bf16_t*)(ws + WS_WIN))
#define P_Wuq ((bf16_t*)(ws + WS_WUQ))
#define P_Wukv ((bf16_t*)(ws + WS_WUKV))
#define P_Wglu ((bf16_t*)(ws + WS_WGLU))
#define P_Wout ((bf16_t*)(ws + WS_WOUT))
#define P_Wup ((bf16_t*)(ws + WS_WUP))
#define P_Wdn ((bf16_t*)(ws + WS_WDN))
#define P_Bst ((bf16_t*)(ws + WS_BST))
#define P_Mout ((bf16_t*)(ws + WS_MOUT))
#define P_KTAB ((float*)(ws + WS_KTAB))
#define P_TAB ((float*)(ws + WS_TAB))
#define P_PART ((float*)(ws + WS_PART))
#define P_PARTA ((float*)(ws + WS_PARTA))
#define P_PARTS ((float*)(ws + WS_PARTS))
#define P_UM ((float*)(ws + WS_UM))
#define P_XN ((bf16_t*)(ws + WS_XN))
#define P_XRS ((float*)(ws + 256 * 1024))
#define P_CQ ((bf16_t*)(ws + WS_CQ))
#define P_UP ((bf16_t*)(ws + WS_UP))
#define P_Q ((bf16_t*)(ws + WS_Q))
#define P_KN ((bf16_t*)(ws + WS_KN))
#define P_VV ((bf16_t*)(ws + WS_VV))
#define P_KR ((bf16_t*)(ws + WS_KR))
#define P_Sst ((float*)(ws + WS_S))
#define P_MIX ((bf16_t*)(ws + WS_MIX))
#define P_Y ((bf16_t*)(ws + WS_Y))
#define P_XN2 ((bf16_t*)(ws + WS_XN2))
#define P_H ((bf16_t*)(ws + WS_H))
#define P_V1 ((float*)(ws + WS_V1))
#define P_M2 ((float*)(ws + WS_M2))

    {
        ARGS_FRESH(); TID_FRESH();
        LAS float* scr = (LAS float*)(lds + wave * 16384);
        constexpr int I0 = 16 * 40, I1 = 6 * 24, I2 = 4 * 32, I3 = 8 * 32, I4 = 16 * 32, I5 = 16 * 128, I6 = 64 * 32;
        constexpr int NITEMS = I0 + I1 + I2 + I3 + I4 + I5 + I6;
        for (int it = gw; it < NITEMS; it += NGW) {
            int r = it;
            if (r < I0) { transpose_item<0>(ap->w_in, 1024, 1280, 1184, ap->g_pre_mix, P_Win, scr, r, lane); continue; } r -= I0;
            if (r < I1) { transpose_item<1>(ap->w_uq, 384, 768, 768, ap->g_q_lat, P_Wuq, scr, r, lane, 512); continue; } r -= I1;
            if (r < I2) { transpose_item<2>(ap->w_ukv, 256, 1024, 1024, ap->g_kv_lat, P_Wukv, scr, r, lane, 512); continue; } r -= I2;
            if (r < I3) { transpose_item<3>(ap->w_glu, 512, 1024, 1024, nullptr, P_Wglu, scr, r, lane); continue; } r -= I3;
            if (r < I4) { transpose_item<4>(ap->w_out, 1024, 1024, 1024, ap->g_mix_out, P_Wout, scr, r, lane); continue; } r -= I4;
            if (r < I5) { transpose_item<5>(ap->w_up, 1024, 4096, 4096, ap->g_pre_mlp, P_Wup, scr, r, lane); continue; } r -= I5;
            transpose_item<6>(ap->w_down, 4096, 1024, 1024, nullptr, P_Wdn, scr, r, lane);
        }
        for (int m0 = gw * 4; m0 < MX + NMETA; m0 += NGW * 4) {
            f32x4 v[4][4]; float ss[4];
#pragma unroll
            for (int r = 0; r < 4; ++r) { const int m = m0 + r; const float* xr = m < MX ? ap->x + (size_t)m * DM : ap->meta + (size_t)(m - MX) * DM;
#pragma unroll
                for (int j = 0; j < 2; ++j) { v[r][2 * j] = __builtin_nontemporal_load((const f32x4*)(xr + 8 * lane + 512 * j)); v[r][2 * j + 1] = __builtin_nontemporal_load((const f32x4*)(xr + 8 * lane + 512 * j + 4)); } }
#pragma unroll
            for (int r = 0; r < 4; ++r) { float s_ = 0.f;
#pragma unroll
                for (int j = 0; j < 4; ++j) s_ += (v[r][j][0] * v[r][j][0] + v[r][j][1] * v[r][j][1]) + (v[r][j][2] * v[r][j][2] + v[r][j][3] * v[r][j][3]);
                ss[r] = s_; }
#pragma unroll
            for (int o_ = 1; o_ < 64; o_ <<= 1) {
#pragma unroll
                for (int r = 0; r < 4; ++r) ss[r] += __shfl_xor(ss[r], o_); }
#pragma unroll
            for (int j = 0; j < 2; ++j) {
#pragma unroll
                for (int r = 0; r < 4; ++r) *(u32x4*)(P_XN + (size_t)(m0 + r) * DM + 8 * lane + 512 * j) = pack8(v[r][2 * j], v[r][2 * j + 1]); }
            if (lane < 4) { float s_ = ss[0]; s_ = lane == 1 ? ss[1] : s_; s_ = lane == 2 ? ss[2] : s_; s_ = lane == 3 ? ss[3] : s_; P_XRS[m0 + lane] = __builtin_amdgcn_rsqf(s_ * (1.f / DM) + EPS); }
        }
        for (int id = gt; id < (MX + NMETA) * 16; id += NGT) {
            const int row = id >> 4, p = id & 15;
            const int pos = row < MX ? ap->positions[row] + NMETA : row - MX;
            const float invq[4] = {1.0f, 0.5623413251903491f, 0.31622776601683794f, 0.1778279410038923f};
            const float dec[4] = {1.0f, 0.1f, 0.01f, 0.001f};
            const float inv = invq[p & 3] * dec[p >> 2];
            const float ang = (float)pos * inv;
            double t = (double)ang * 0.15915494309189535; t -= __builtin_rint(t); const float f = (float)t;
            P_TAB[(size_t)row * 32 + p] = __builtin_amdgcn_cosf(f); P_TAB[(size_t)row * 32 + 16 + p] = __builtin_amdgcn_sinf(f);
        }
        for (int un = gw; un < 32 * 2 * 32; un += NGW) {
            const int d = un & 31, dir = (un >> 5) & 1, g = un >> 6, p = lane;
            const SsmP sp = ssm_params(ap->A_re, ap->A_im, ap->log_dt, dir, g, p);
            float wr_, wi_; lam_pow(sp.lr, sp.li, sp.dt, (float)d, wr_, wi_);
            const float wqr = wr_ * sp.qr - wi_ * sp.qi, wqi = wr_ * sp.qi + wi_ * sp.qr;
            const float* Br = ap->B_re + ((size_t)(dir * 32 + g) * 64 + p) * 16; const float* Bi = ap->B_im + ((size_t)(dir * 32 + g) * 64 + p) * 16;
#pragma unroll
            for (int hh = 0; hh < 16; ++hh) { const float br = Br[hh], bi = Bi[hh]; scr[(p * 16 + hh) * 2] = wqr * br - wqi * bi; scr[(p * 16 + hh) * 2 + 1] = wqr * bi + wqi * br; }
            LDS_WAIT(); asm volatile("" ::: "memory");
            const int h = lane >> 2, hp0 = (lane & 3) * 4;
            const float* Cr = ap->C_re + ((size_t)(dir * 32 + g) * 16 + h) * 64; const float* Ci = ap->C_im + ((size_t)(dir * 32 + g) * 16 + h) * 64;
            f32x4 accv = {0.f, 0.f, 0.f, 0.f};
            f32x4 crv[16], civ[16];
#pragma unroll
            for (int q4 = 0; q4 < 16; ++q4) { crv[q4] = *(const f32x4*)(Cr + 4 * q4); civ[q4] = *(const f32x4*)(Ci + 4 * q4); }
#pragma unroll
            for (int pp = 0; pp < 64; ++pp) { const float cr = crv[pp >> 2][pp & 3], ci = civ[pp >> 2][pp & 3];
#pragma unroll
                for (int e = 0; e < 4; ++e) accv[e] += cr * scr[(pp * 16 + hp0 + e) * 2] - ci * scr[(pp * 16 + hp0 + e) * 2 + 1]; }
            *(f32x4*)(P_KTAB + ((size_t)((g * 2 + dir) * 32 + d)) * 256 + lane * 4) = accv;
            LDS_WAIT(); asm volatile("" ::: "memory");
        }
        for (int id = gt; id < 32 * 2 * 32 * 64; id += NGT) {
            const int p = id & 63, j = (id >> 6) & 31, dir = (id >> 11) & 1, g = id >> 12;
            const SsmP sp = ssm_params(ap->A_re, ap->A_im, ap->log_dt, dir, g, p);
            {
                float wr_, wi_; lam_pow(sp.lr, sp.li, sp.dt, dir == 0 ? (float)(31 - j) : (float)j, wr_, wi_);
                const float wqr = wr_ * sp.qr - wi_ * sp.qi, wqi = wr_ * sp.qi + wi_ * sp.qr;
                const float* Br = ap->B_re + ((size_t)(dir * 32 + g) * 64 + p) * 16; const float* Bi = ap->B_im + ((size_t)(dir * 32 + g) * 64 + p) * 16;
                float er[16], ei[16];
#pragma unroll
                for (int hh = 0; hh < 16; ++hh) { const float br = Br[hh], bi = Bi[hh]; er[hh] = wqr * br - wqi * bi; ei[hh] = wqr * bi + wqi * br; }
                bf16_t* dre = P_Bst + ((size_t)(g * 256 + dir * 128 + p)) * 512 + j * 16; bf16_t* dim_ = dre + (size_t)64 * 512;
                u32x4 w;
                w.x = cvt_pk_bf16(er[0], er[1]); w.y = cvt_pk_bf16(er[2], er[3]); w.z = cvt_pk_bf16(er[4], er[5]); w.w = cvt_pk_bf16(er[6], er[7]); *(u32x4*)dre = w;
                w.x = cvt_pk_bf16(er[8], er[9]); w.y = cvt_pk_bf16(er[10], er[11]); w.z = cvt_pk_bf16(er[12], er[13]); w.w = cvt_pk_bf16(er[14], er[15]); *(u32x4*)(dre + 8) = w;
                w.x = cvt_pk_bf16(ei[0], ei[1]); w.y = cvt_pk_bf16(ei[2], ei[3]); w.z = cvt_pk_bf16(ei[4], ei[5]); w.w = cvt_pk_bf16(ei[6], ei[7]); *(u32x4*)dim_ = w;
                w.x = cvt_pk_bf16(ei[8], ei[9]); w.y = cvt_pk_bf16(ei[10], ei[11]); w.z = cvt_pk_bf16(ei[12], ei[13]); w.w = cvt_pk_bf16(ei[14], ei[15]); *(u32x4*)(dim_ + 8) = w;
            }
            {
                const int i = j; float wr_, wi_; lam_pow(sp.lr, sp.li, sp.dt, dir == 0 ? (float)(i + 1) : (float)(32 - i), wr_, wi_);
                const float* Cr = ap->C_re + ((size_t)(dir * 32 + g) * 16) * 64 + p; const float* Ci = ap->C_im + ((size_t)(dir * 32 + g) * 16) * 64 + p;
                bf16_t* d0 = P_Mout + ((size_t)(g * 512 + i * 16)) * 768 + 512 + dir * 128 + p;
#pragma unroll
                for (int hh = 0; hh < 16; ++hh) { const float cr = Cr[hh * 64], ci = Ci[hh * 64]; const float zr = cr * wr_ - ci * wi_, zi = cr * wi_ + ci * wr_;
                    d0[(size_t)hh * 768] = f2bf(zr); d0[(size_t)hh * 768 + 64] = f2bf(-zi); }
            }
        }
        for (int id = gt; id < NB * 48 * 64; id += NGT) { const int c = id & 63, r = (id >> 6) % 48, b = id / (48 * 64); const size_t row = (size_t)b * KVR + SEQ + NMETA + r;
            const u32x4 z = {0u, 0u, 0u, 0u}; *(u32x4*)(P_KN + row * 512 + c * 8) = z; *(u32x4*)(P_VV + row * 512 + c * 8) = z; if (c < 4) *(u32x4*)(P_KR + row * 32 + c * 8) = z; }
    }
    if (__builtin_expect(ws == nullptr, 0)) grid.sync();
    XBAR();
    STAMP(1);
    if (wave == 0) {
        const int l_ = tid_of(wave) & 63; unsigned* bw_ = (unsigned*)(ws + WS_BAR);
        const unsigned v_ = (G == 256 && l_ < 32) ? xb_ld(bw_ + XL_ID + (bid & 7) + 8 * l_) : my_xcc;
        if (!__all(v_ == my_xcc) && l_ == 0) __hip_atomic_store(bw_ + XL_FLAG, 1u, RLX_AGENT);
    }

    {
        ARGS_FRESH(); TID_FRESH();
        for (int id0 = gt; id0 < 32 * 32 * 16 * 32 * 2; id0 += 8 * NGT) {
            f32x4 a0[8], a1[8], c0[8], c1[8]; float dd[8];
#pragma unroll
            for (int q = 0; q < 8; ++q) { const int id = id0 + q * NGT; a0[q] = (f32x4){0.f, 0.f, 0.f, 0.f}; a1[q] = a0[q]; c0[q] = a0[q]; c1[q] = a0[q]; dd[q] = 0.f;
                if (id < 32 * 32 * 16 * 32 * 2) {
                    const int h8 = id & 1, j = (id >> 1) & 31, h = (id >> 6) & 15, i = (id >> 10) & 31, g = id >> 15;
                    const float* kf = P_KTAB + ((size_t)((g * 2 + 0) * 32)) * 256 + h * 16 + h8 * 8; const float* kb = P_KTAB + ((size_t)((g * 2 + 1) * 32)) * 256 + h * 16 + h8 * 8;
                    const float* s = (j < i) ? kf + (size_t)(i - j) * 256 : kb + (size_t)(j - i) * 256;
                    a0[q] = *(const f32x4*)s; a1[q] = *(const f32x4*)(s + 4);
                    if (j == i) { c0[q] = *(const f32x4*)kf; c1[q] = *(const f32x4*)(kf + 4); dd[q] = ap->Dv[g * 16 + h]; } } }
#pragma unroll
            for (int q = 0; q < 8; ++q) { const int id = id0 + q * NGT;
                if (id < 32 * 32 * 16 * 32 * 2) {
                    const int h8 = id & 1, j = (id >> 1) & 31, h = (id >> 6) & 15, i = (id >> 10) & 31, g = id >> 15;
                    f32x4 v0 = a0[q] + c0[q], v1 = a1[q] + c1[q];
                    if (j == i) { const int e = h - h8 * 8; if (e >= 0 && e < 4) v0[e] += dd[q]; else if (e >= 4 && e < 8) v1[e - 4] += dd[q]; }
                    *(u32x4*)(P_Mout + ((size_t)(g * 512 + i * 16 + h)) * 768 + j * 16 + h8 * 8) = pack8(v0, v1); } }
        }
        pg8::Gemm g{P_XN, P_Win, 1024, 1024, 1024, 0, 0}; pg8::Order S; S.init(MT / 256, 5, 1, G, bid);
        LAS float* rtab = (LAS float*)(lds + TAB_OFF);
        { Unit u; const int r_ = tid & 255; for (int ui = tid >> 8; S.next(ui, u); ui += 2) { const int row = u.pm * 256 + r_; rtab[ui * 256 + r_] = row < MX + NMETA ? P_XRS[row] : 0.f; } }
        __syncthreads();
        EpiProj E{P_CQ, P_UP, P_KR, P_PART, P_UM, P_TAB, rtab};
        pg8::gemm_phase<EpiProj, true>(lds, g, S, E, wave);
    }
    XBAR();
    STAMP(2);

    {
        TID_FRESH();
        struct Order2 { pg8::Order oq, okv, ost; int G, c;
            __device__ __forceinline__ bool next(int i, Unit& u) const { const long L = (long)i * G + c;
                if (L < 128) { u.ty = 2; return ost.decode(L, u); }
                if (L < 128 + 384) { u.ty = 0; return oq.decode(L - 128, u); }
                u.ty = 1; return okv.decode(L - 512, u); } };
        Order2 S; S.G = G; S.c = bid; S.oq.init(MX / 256, 3, 1, G, 0); S.okv.init(MT / 256, 4, 1, G, 0); S.ost.init(NCH / 256, 1, 32, G, 0);
        LAS f32x2* tab = (LAS f32x2*)(lds + TAB_OFF);
        { Unit u; const int r_ = tid & 255; for (int ui = tid >> 8; S.next(ui, u); ui += 2) if (u.ty != 2) {
              const float* pp = P_PART + (size_t)(u.pm * 256 + r_) * 20;
              tab[ui * 256 + r_] = (f32x2){u.ty == 0 ? rstd_from(pp, 3, 1.0f / 384.0f) * QSCALE : rstd_from(pp + 12, 2, 1.0f / 256.0f), 0.f}; } }
        __syncthreads();
        pg8::Gemm3 g3;
        g3.A[0] = P_CQ; g3.A[1] = P_CQ + 384; g3.A[2] = P_UP; g3.Bt[0] = P_Wuq; g3.Bt[1] = P_Wukv; g3.Bt[2] = P_Bst;
        g3.nt[0] = 6; g3.nt[1] = 4; g3.nt[2] = 8; g3.gsA[0] = 0; g3.gsA[1] = 0; g3.gsA[2] = (size_t)NCH * 768; g3.gsB[0] = 0; g3.gsB[1] = 0; g3.gsB[2] = (size_t)256 * 512;
        g3.lda = 768; g3.ldb = 512;
        EpiQ E0{P_Q, tab, P_TAB}; EpiKV E1{P_KN, P_VV, tab}; EpiState E2{P_Sst};
        pg8::gemm_phase_multi<Order2, EpiQ, EpiKV, EpiState, true>(lds, g3, S, E0, E1, E2, wave);
    }
    XBAR();
    STAMP(3);
    const bool xl_use = (G == 256) && (__builtin_amdgcn_readfirstlane((int)xb_ld((unsigned*)(ws + WS_BAR) + XL_FLAG)) == 0);
#define XLBAR(k) do { if (xl_use) xl_barrier((unsigned*)(ws + WS_BAR), (unsigned*)(ws + WS_BAR) + XL_CNT(bid & 7, k), 32u); else XBAR(); } while (0)

    {
        LAS float* sl = (LAS float*)lds;
        ARGS_FRESH(); TID_FRESH();
        for (int idx = bid; idx < NB * 2 * 32; idx += G) {
            const int jx_ = idx >> 3, g = (G == 256) ? 4 * (idx & 7) + (jx_ & 3) : (idx & 31), dir = (G == 256) ? ((jx_ >> 2) & 1) : ((idx >> 5) & 1), b = (G == 256) ? (jx_ >> 3) : (idx >> 6), p = lane;
            const SsmP sp = ssm_params(ap->A_re, ap->A_im, ap->log_dt, dir, g, p);
            float aTr, aTi; lam_pow(sp.lr, sp.li, sp.dt, 32.f, aTr, aTi);
            float aSr, aSi; lam_pow(sp.lr, sp.li, sp.dt, 1024.f, aSr, aSi);
            float mr0 = 0.f, mi0 = 0.f;
            if (dir == 0) {
                const float* Br = ap->B_re + ((size_t)(g) * 64 + p) * 16; const float* Bi = ap->B_im + ((size_t)(g) * 64 + p) * 16;
                float brv[16], biv[16];
#pragma unroll
                for (int hh = 0; hh < 16; ++hh) { brv[hh] = Br[hh]; biv[hh] = Bi[hh]; }
#pragma unroll 4
                for (int j = 0; j < NMETA; ++j) {
                    float ur = 0.f, ui = 0.f;
#pragma unroll
                    for (int hh = 0; hh < 16; ++hh) { const float uu = P_UM[j * 512 + g * 16 + hh]; ur += brv[hh] * uu; ui += biv[hh] * uu; }
                    const float br = sp.qr * ur - sp.qi * ui, bi = sp.qr * ui + sp.qi * ur;
                    float pr, pi; lam_pow(sp.lr, sp.li, sp.dt, (float)(NMETA - 1 - j), pr, pi);
                    mr0 += pr * br - pi * bi; mi0 += pr * bi + pi * br;
                }
            }
            const int c0 = b * 256 + wave * 32;
            float sre[32], sim[32];
#pragma unroll
            for (int k = 0; k < 32; ++k) { const float* s = P_Sst + ((size_t)g * NCH + c0 + k) * 256 + dir * 128 + p; sre[k] = s[0]; sim[k] = s[64]; }
            float xr = 0.f, xi = 0.f;
            if (dir == 0) {
#pragma unroll
                for (int k = 0; k < 32; ++k) { const float nr = aTr * xr - aTi * xi + sre[k], ni = aTr * xi + aTi * xr + sim[k]; xr = nr; xi = ni; }
            } else {
#pragma unroll
                for (int k = 31; k >= 0; --k) { const float nr = aTr * xr - aTi * xi + sre[k], ni = aTr * xi + aTi * xr + sim[k]; xr = nr; xi = ni; }
            }
            sl[(wave * 64 + p) * 2] = xr; sl[(wave * 64 + p) * 2 + 1] = xi;
            __syncthreads();
            float cr = 0.f, ci = 0.f;
            if (dir == 0) {
                cr = mr0; ci = mi0;
                for (int w = 0; w < wave; ++w) { const float tr = sl[(w * 64 + p) * 2], ti = sl[(w * 64 + p) * 2 + 1];
                    const float nr = aSr * cr - aSi * ci + tr, ni = aSr * ci + aSi * cr + ti; cr = nr; ci = ni; }
                xr = cr; xi = ci;
#pragma unroll
                for (int k = 0; k < 32; ++k) {
                    bf16_t* d = P_UP + ((size_t)g * NCH + c0 + k) * 768 + 512 + p; d[0] = f2bf(xr); d[64] = f2bf(xi);
                    const float nr = aTr * xr - aTi * xi + sre[k], ni = aTr * xi + aTi * xr + sim[k]; xr = nr; xi = ni; }
            } else {
                for (int w = NWAVES - 1; w > wave; --w) { const float tr = sl[(w * 64 + p) * 2], ti = sl[(w * 64 + p) * 2 + 1];
                    const float nr = aSr * cr - aSi * ci + tr, ni = aSr * ci + aSi * cr + ti; cr = nr; ci = ni; }
                xr = cr; xi = ci;
#pragma unroll
                for (int k = 31; k >= 0; --k) {
                    bf16_t* d = P_UP + ((size_t)g * NCH + c0 + k) * 768 + 512 + 128 + p; d[0] = f2bf(xr); d[64] = f2bf(xi);
                    const float nr = aTr * xr - aTi * xi + sre[k], ni = aTr * xi + aTi * xr + sim[k]; xr = nr; xi = ni; }
            }
            __syncthreads();
        }
        const int vcu = (G % 8 == 0) ? (bid % 8) * (G / 8) + bid / 8 : bid;
        for (int L = vcu; L < NB * 8 * 32; L += G) {
            const int bh = L >> 5, qb = L & 31;
            if (!attn::attn_unit<false>(bh >> 3, bh & 7, qb, P_Q, P_KN, P_KR, P_VV, P_MIX, P_PARTA, (char*)lds_raw, (const LAS char*)lds, wave))
                (void)attn::attn_unit<true>(bh >> 3, bh & 7, qb, P_Q, P_KN, P_KR, P_VV, P_MIX, P_PARTA, (char*)lds_raw, (const LAS char*)lds, wave);
        }
    }
    XLBAR(3);
    STAMP(4);

    { pg8::Gemm g{P_UP, P_Mout, 768, 768, 768, (size_t)NCH * 768, (size_t)512 * 768}; pg8::Order S; S.init(NCH / 256, 2, 32, G, bid);
      EpiY E{P_Y}; pg8::gemm_phase<EpiY, true>(lds, g, S, E, wave); }
    XBAR();
    STAMP(5);
    { pg8::Gemm g{P_Y, P_Wglu, 512, 512, 512, 0, 0}; pg8::Order S; S.init(MX / 256, 4, 1, G, bid);
      EpiGLU E{P_MIX, P_PARTS}; pg8::gemm_phase<EpiGLU, true>(lds, g, S, E, wave); }
    XLBAR(0);
    STAMP(6);
    { ARGS_FRESH(); TID_FRESH();
      pg8::Gemm g{P_MIX, P_Wout, 1024, 1024, 1024, 0, 0}; pg8::Order S; S.init(MX / 256, 4, 1, G, bid);
      LAS f32x2* tab = (LAS f32x2*)(lds + TAB_OFF);
      { Unit u; const int r_ = tid & 255; for (int ui = tid >> 8; S.next(ui, u); ui += 2) { const int row = u.pm * 256 + r_;
            const float ra = rstd_from(P_PARTA + (size_t)row * 8, 2, 1.0f / 512.0f), rs = rstd_from(P_PARTS + (size_t)row * 16, 4, 1.0f / 512.0f);
            tab[ui * 256 + r_] = (f32x2){ra / rs, rs}; } }
      __syncthreads();
      unsigned* cntb = (unsigned*)(ws + WS_CNT); float* xb = (float*)(ws + WS_XB);
      PanelRms st1{xb, cntb, (unsigned*)(ws + WS_BAR) + XB_TMO};
      EpiWoutLN E{P_XN, P_XN2, P_TAB, ap->g_post_mix, tab, lds + TAB_OFF + 4096, st1};
      pg8::gemm_phase<EpiWoutLN, true>(lds, g, S, E, wave); }
    XLBAR(1);
    STAMP(7);
    STAMP(8);
    { TID_FRESH();
      pg8::Gemm g{P_XN2, P_Wup, 1024, 1024, 1024, 0, 0}; pg8::Order S; S.init(MX / 256, 16, 1, G, bid); S.rev = 1;
      LAS float* tabf = (LAS float*)(lds + TAB_OFF);
      { Unit u; for (int ui = wave; S.next(ui, u); ui += NWAVES) {
            f32x4 v[4][8];
#pragma unroll
            for (int r = 0; r < 4; ++r) { const float* pp = P_TAB + (size_t)(u.pm * 256 + lane + 64 * r) * 32;
#pragma unroll
                for (int i = 0; i < 8; ++i) v[r][i] = *(const f32x4*)(pp + 4 * i); }
#pragma unroll
            for (int r = 0; r < 4; ++r) { float ssq = 0.f;
#pragma unroll
                for (int i = 0; i < 8; ++i) ssq += (v[r][i][0] + v[r][i][1]) + (v[r][i][2] + v[r][i][3]);
                tabf[ui * 256 + lane + 64 * r] = __builtin_amdgcn_rcpf(ssq * (1.0f / 1024.0f) + EPS); } } }
      __syncthreads();
      EpiRelu2 E{P_H, tabf}; pg8::gemm_phase<EpiRelu2, true>(lds, g, S, E, wave); }
    XLBAR(2);
    STAMP(9);
    { ARGS_FRESH();
      pg8::Gemm g{P_H, P_Wdn, 4096, 4096, 4096, 0, 0}; pg8::Order S; S.init(MX / 256, 4, 1, G, bid);
      PanelRms st{(float*)(ws + WS_XB) + 2 * 131072, (unsigned*)(ws + WS_CNT) + 2 * 128 * 64, (unsigned*)(ws + WS_BAR) + XB_TMO};
      EpiDownLN E{ap->out, P_XN2, ap->g_post_mlp, lds + TAB_OFF + 4096, st};
      pg8::gemm_phase<EpiDownLN, true>(lds, g, S, E, wave); }
    STAMP(10);
    if (PROBE_A >= 0 && blockIdx.x == 0 && tid_of(wave) == 0) {
        asm volatile("s_waitcnt vmcnt(0)" ::: "memory");
        const unsigned long long t1 = PROBE_B >= 11 ? __builtin_amdgcn_s_memrealtime() : ((volatile unsigned long long*)ws)[PROBE_B < 11 ? PROBE_B : 0];
        const unsigned long long t0 = ((volatile unsigned long long*)ws)[PROBE_A >= 0 ? PROBE_A : 0];
        ap0->out[0] = (float)(long long)(t1 - t0) * 0.01f;
    }
}

extern "C" void kernel_launch(void* const* d_in, const int* in_sizes, int n_in, void* d_out, int out_size, void* d_ws, size_t ws_size, hipStream_t stream) {
    static int grid = 0;
    if (grid == 0) {
        if (n_in != 25 || out_size != MX * DM || ws_size < WS_END) { fprintf(stderr, "kernel_launch: unexpected shapes n_in %d out %d ws %zu\n", n_in, out_size, ws_size); grid = -1; return; }
        int dev = 0, cus = 0, per_cu = 0;
        (void)hipGetDevice(&dev);
        (void)hipDeviceGetAttribute(&cus, hipDeviceAttributeMultiprocessorCount, dev);
        (void)hipFuncSetAttribute((const void*)fwd_megakernel, hipFuncAttributeMaxDynamicSharedMemorySize, LDS_BYTES);
        (void)hipOccupancyMaxActiveBlocksPerMultiprocessor(&per_cu, (const void*)fwd_megakernel, NTHR, LDS_BYTES);
        if (per_cu < 1) { fprintf(stderr, "kernel_launch: occupancy query says %d\n", per_cu); grid = -1; return; }
        grid = cus * 1;
        fprintf(stderr, "kernel_launch: cus %d per_cu %d grid %d ws %zu\n", cus, per_cu, grid, ws_size);
    }
    if (grid < 0) return;
    Args a{};
    const float** fp = (const float**)&a;
    a.x = (const float*)d_in[0]; a.positions = (const int*)d_in[1]; a.meta = (const float*)d_in[2];
    a.g_pre_mix = (const float*)d_in[3]; a.w_in = (const float*)d_in[4]; a.g_q_lat = (const float*)d_in[5]; a.w_uq = (const float*)d_in[6]; a.g_kv_lat = (const float*)d_in[7]; a.w_ukv = (const float*)d_in[8];
    a.A_re = (const float*)d_in[9]; a.A_im = (const float*)d_in[10]; a.log_dt = (const float*)d_in[11]; a.B_re = (const float*)d_in[12]; a.B_im = (const float*)d_in[13]; a.C_re = (const float*)d_in[14]; a.C_im = (const float*)d_in[15];
    a.Dv = (const float*)d_in[16]; a.w_glu = (const float*)d_in[17]; a.g_mix_out = (const float*)d_in[18]; a.w_out = (const float*)d_in[19]; a.g_post_mix = (const float*)d_in[20]; a.g_pre_mlp = (const float*)d_in[21];
    a.w_up = (const float*)d_in[22]; a.w_down = (const float*)d_in[23]; a.g_post_mlp = (const float*)d_in[24];
    (void)fp;
    a.out = (float*)d_out; a.ws = (unsigned char*)d_ws;
    (void)hipMemsetAsync((char*)d_ws + WS_BAR, 0, (WS_CNT - WS_BAR) + 3 * 128 * 64 * 4, stream);
    void* args[] = {&a};
    hipError_t e = hipLaunchCooperativeKernel((const void*)fwd_megakernel, dim3(grid), dim3(NTHR), args, LDS_BYTES, stream);
    if (e != hipSuccess) fprintf(stderr, "cooperative launch failed: %s (grid %d)\n", hipGetErrorString(e), grid);
}
```

```cpp
#include <hip/hip_runtime.h>
#include <hip/hip_cooperative_groups.h>
#include <cstdio>
#include <cstdint>
namespace cg = cooperative_groups;
#define PROBE_A (-1)
#define PROBE_B 0

#define LAS __attribute__((address_space(3)))
typedef unsigned short bf16_t;
typedef short bf16x8 __attribute__((ext_vector_type(8)));
typedef short s16x4 __attribute__((ext_vector_type(4)));
typedef float f32x4 __attribute__((ext_vector_type(4)));
typedef float f32x2 __attribute__((ext_vector_type(2)));
typedef float f32x16 __attribute__((ext_vector_type(16)));
typedef unsigned u32x4 __attribute__((ext_vector_type(4)));
typedef unsigned u32x2 __attribute__((ext_vector_type(2)));

constexpr int NB = 4, SEQ = 8192, NMETA = 16, DM = 1024, DFF = 4096;
constexpr int MX = NB * SEQ;
constexpr int MT = MX + 256;
constexpr int KVR = 8256;
constexpr int NCH = 1024;
constexpr float EPS = 1e-6f;
constexpr int NWAVES = 8, NTHR = 512;
constexpr int LDS_BYTES = 147456;
constexpr int TAB_OFF = 131072;
constexpr int XBST_OFF = LDS_BYTES - 64;
constexpr float QSCALE = 0.10206207261596577f * 1.4426950408889634f;

constexpr size_t MiB = 1u << 20;
constexpr size_t WS_UM = 512 * 1024;
constexpr size_t WS_WIN = 1 * MiB, WS_WUQ = 4 * MiB, WS_WUKV = 5 * MiB, WS_WGLU = 6 * MiB, WS_WOUT = 7 * MiB, WS_WUP = 9 * MiB, WS_WDN = 17 * MiB;
constexpr size_t WS_BST = 25 * MiB, WS_MOUT = 33 * MiB, WS_KTAB = 57 * MiB, WS_TAB = 59 * MiB, WS_PART = 64 * MiB, WS_PARTA = 67 * MiB, WS_PARTS = 68 * MiB;
constexpr size_t WS_XN = 72 * MiB, WS_CQ = 137 * MiB  , WS_UP = 188 * MiB, WS_S = 236 * MiB, WS_Q = 268 * MiB, WS_KN = 316 * MiB, WS_VV = 349 * MiB, WS_KR = 382 * MiB;
constexpr size_t WS_MIX = 392 * MiB, WS_Y = 456 * MiB;
constexpr size_t WS_V1 = 72 * MiB, WS_XN2 = 328 * MiB, WS_H = 72 * MiB, WS_M2 = 328 * MiB, WS_END = 490 * MiB;

__device__ __forceinline__ unsigned cvt_pk_bf16(float lo, float hi) { unsigned r; asm volatile("v_cvt_pk_bf16_f32 %0, %1, %2" : "=v"(r) : "v"(lo), "v"(hi)); return r; }
__device__ __forceinline__ bf16_t f2bf(float f) { return (bf16_t)(cvt_pk_bf16(f, 0.f) & 0xffffu); }
__device__ __forceinline__ u32x4 pack8(f32x4 a, f32x4 b) { u32x4 w; w.x = cvt_pk_bf16(a[0], a[1]); w.y = cvt_pk_bf16(a[2], a[3]); w.z = cvt_pk_bf16(b[0], b[1]); w.w = cvt_pk_bf16(b[2], b[3]); return w; }
__device__ __forceinline__ float wave_sum(float v) {
#pragma unroll
    for (int o = 1; o < 64; o <<= 1) v += __shfl_xor(v, o);
    return v;
}
#define LDS_WAIT() asm volatile("s_waitcnt lgkmcnt(0)" ::: "memory")
__device__ __forceinline__ int tid_of(int wave) { return wave * 64 + (int)__builtin_amdgcn_mbcnt_hi(~0u, __builtin_amdgcn_mbcnt_lo(~0u, 0u)); }

namespace pg8 {
constexpr int BM = 256, BK = 64, HALF = 128, HTB = HALF * BK * 2, STAGE_BYTES = 8 * HTB, NXCD = 8, WGM = 8;
__device__ __forceinline__ int lds_byte(int r, int c) { const int st = (r >> 4) * 2 + (c >> 5), rr = r & 15, cc = c & 31, ob = rr * 64 + cc * 2; return st * 1024 + (ob ^ (((ob >> 9) & 1) << 5)); }
__device__ __forceinline__ void stage_rc(int b, int& R, int& C) { const int st = b / 1024, sb = b % 1024, swz = sb ^ (((sb >> 9) & 1) << 5); R = (st >> 1) * 16 + swz / 64; C = (st & 1) * 32 + (swz % 64) / 2; }
__device__ __forceinline__ int perm32(int rho) { const int n = rho >> 4, i = rho & 15; return 8 * (i >> 2) + 4 * n + (i & 3); }

struct Unit { int pm, pn, pg, ui, ty; };
struct Gemm { const bf16_t* A; const bf16_t* Bt; int lda, ldb, K; size_t gsA, gsB; };

struct Order {
    int nM, nN, per, nwg, G, c, rev = 0;
    __device__ __forceinline__ void init(int nM_, int nN_, int nG_, int G_, int c_) { nM = nM_; nN = nN_; per = nM_ * nN_; nwg = per * nG_; G = G_; c = c_; }
    __device__ __forceinline__ bool next(int i, Unit& u) const { const int nr = (nwg + G - 1) / G; if (i >= nr) return false;
        const bool rv = rev && (nwg % G == 0);
        return decode((long)(rv ? nr - 1 - i : i) * G + c, u); }
    __device__ __forceinline__ bool decode(long L, Unit& u) const {
        if (L >= nwg) return false;
        int wgid = (int)L; { const int q = nwg / NXCD, r = nwg % NXCD, xcd = wgid % NXCD, off = wgid / NXCD; wgid = (xcd < r ? xcd * (q + 1) : r * (q + 1) + (xcd - r) * q) + off; }
        const int pg = wgid / per, w = wgid % per;
        const int nig = WGM * nN, gid = w / nig, fm = gid * WGM, gsz = (nM - fm) < WGM ? (nM - fm) : WGM;
        u.pm = fm + ((w % nig) % gsz); u.pn = (w % nig) / gsz; u.pg = pg; return true;
    }
};

template <class Epi, bool ALIGN_EPI>
__device__ __forceinline__ void gemm_phase(LAS unsigned char* lds, const Gemm g, const Order& S, const Epi& E, const int wid) {
    int tid = tid_of(wid); asm volatile("" : "+v"(tid));
    const int lane = tid & 63, wr = wid >> 2, wc = wid & 3; int fr = lane & 15, fq = lane >> 4;
    const int K = g.K, nt = K / BK;
    unsigned voffA[2], voffB[2];
#pragma unroll
    for (int i = 0; i < 2; ++i) { int R, C; stage_rc(tid * 16 + i * 8192, R, C); const int Rb = Epi::PERM ? ((R & ~31) + perm32(R & 31)) : R;
        voffA[i] = (unsigned)(R * g.lda + C) * 2u; voffB[i] = (unsigned)(Rb * g.ldb + C) * 2u; }
    const size_t kstep = (size_t)(BK * 2);
    const size_t hstepA = (size_t)HALF * g.lda * 2, hstepB = (size_t)HALF * g.ldb * 2;
    const size_t tstepA = 2 * hstepA, tstepB = 2 * hstepB;
    const unsigned ldsw = (unsigned)wid * 1024u;
    const int aoff = lds_byte(wr * 64 + fr, fq * 8), boff = lds_byte(wc * 32 + fr, fq * 8);
#define PG8_SA(b, h) (((b) * 2 + (h)) * HTB)
#define PG8_SB(b, h) ((4 + (b) * 2 + (h)) * HTB)
#define PG8_STAGE(bufoff, gbase, voff) do { _Pragma("unroll") for (int _i = 0; _i < 2; ++_i) \
        __builtin_amdgcn_global_load_lds((const unsigned*)((const char*)(gbase) + (voff)[_i]), (LAS unsigned*)(lds + (bufoff) + ldsw + _i * 8192), 16, 0, 0); } while (0)
#define PG8_LDA(dst, b, h) do { _Pragma("unroll") for (int m = 0; m < 4; ++m) _Pragma("unroll") for (int k = 0; k < 2; ++k) dst[m][k] = *(const LAS bf16x8*)(lds + PG8_SA(b, h) + aoff + m * 2048 + k * 1024); } while (0)
#define PG8_LDB(dst, b, h) do { _Pragma("unroll") for (int n = 0; n < 2; ++n) _Pragma("unroll") for (int k = 0; k < 2; ++k) dst[n][k] = *(const LAS bf16x8*)(lds + PG8_SB(b, h) + boff + n * 2048 + k * 1024); } while (0)
#define PG8_MMA(ai, bj, At, Bt) do { __builtin_amdgcn_s_setprio(1); _Pragma("unroll") for (int m = 0; m < 4; ++m) _Pragma("unroll") for (int n = 0; n < 2; ++n) _Pragma("unroll") for (int k = 0; k < 2; ++k) \
        acc[ai][bj][m][n] = __builtin_amdgcn_mfma_f32_16x16x32_bf16(Bt[n][k], At[m][k], acc[ai][bj][m][n], 0, 0, 0); __builtin_amdgcn_s_setprio(0); } while (0)
#define PG8_WAIT_V(n) asm volatile("s_waitcnt vmcnt(" #n ")" ::: "memory")
#define PG8_WAIT_L(n) asm volatile("s_waitcnt lgkmcnt(" #n ")" ::: "memory")
#define PG8_BAR __builtin_amdgcn_s_barrier()
#define PG8_SCHED __builtin_amdgcn_sched_barrier(0)
    Unit cur, nxt; int ui = 0;
    if (!S.next(0, cur)) return;
    cur.ui = 0;
    f32x4 acc[2][2][4][2];
#pragma unroll
    for (int a = 0; a < 2; ++a)
#pragma unroll
        for (int b = 0; b < 2; ++b)
#pragma unroll
            for (int m = 0; m < 4; ++m)
#pragma unroll
                for (int n = 0; n < 2; ++n) acc[a][b][m][n] = (f32x4){0.f, 0.f, 0.f, 0.f};
    bf16x8 At[4][2], B0[2][2], B1[2][2];
    bool fresh = false;
    const char* cA = (const char*)g.A + ((size_t)cur.pg * g.gsA) * 2 + (size_t)cur.pm * tstepA; const char* cB = (const char*)g.Bt + ((size_t)cur.pg * g.gsB) * 2 + (size_t)cur.pn * tstepB;
    PG8_STAGE(PG8_SB(0, 0), cB, voffB); PG8_STAGE(PG8_SB(0, 1), cB + hstepB, voffB); PG8_STAGE(PG8_SA(0, 0), cA, voffA); PG8_STAGE(PG8_SA(0, 1), cA + hstepA, voffA);
    if (wr == 1) PG8_BAR;
    PG8_WAIT_V(2); PG8_BAR;
    PG8_STAGE(PG8_SB(1, 0), cB + kstep, voffB); PG8_STAGE(PG8_SA(1, 0), cA + kstep, voffA); PG8_STAGE(PG8_SB(1, 1), cB + hstepB + kstep, voffB);
    PG8_WAIT_V(6); PG8_BAR;
    for (;;) {
        const bool has_next = S.next(ui + 1, nxt); nxt.ui = ui + 1;
        const char* nA = has_next ? (const char*)g.A + ((size_t)nxt.pg * g.gsA) * 2 + (size_t)nxt.pm * tstepA : cA;
        const char* nB = has_next ? (const char*)g.Bt + ((size_t)nxt.pg * g.gsB) * 2 + (size_t)nxt.pn * tstepB : cB;
#pragma unroll 1
        for (int t = 0; t < nt; t += 2) {
            if constexpr (Epi::MID) { if (t == (nt >> 1)) E.mid(acc, cur, wr, wc, fr, fq); }
            const bool last = (t == nt - 2);
            const char* a1 = cA + (size_t)(t + 1) * kstep;
            const char* a2 = last ? nA : cA + (size_t)(t + 2) * kstep; const char* b2 = last ? nB : cB + (size_t)(t + 2) * kstep;
            const char* a3 = a2 + kstep; const char* b3 = b2 + kstep;
            PG8_LDB(B0, 0, 0); PG8_LDB(B1, 0, 1); PG8_SCHED; PG8_LDA(At, 0, 0); PG8_STAGE(PG8_SA(1, 1), a1 + hstepA, voffA);
            if (!fresh) PG8_WAIT_V(8); PG8_WAIT_L(0); PG8_BAR; PG8_MMA(0, 0, At, B0); PG8_MMA(0, 1, At, B1); PG8_BAR; PG8_SCHED;
            PG8_LDA(At, 0, 1); PG8_STAGE(PG8_SB(0, 0), b2, voffB); PG8_STAGE(PG8_SB(0, 1), b2 + hstepB, voffB); PG8_STAGE(PG8_SA(0, 0), a2, voffA);
            PG8_WAIT_V(8); PG8_WAIT_L(0); PG8_BAR; PG8_MMA(1, 0, At, B0); PG8_MMA(1, 1, At, B1); PG8_BAR; PG8_SCHED;
            fresh = false;
            PG8_LDB(B0, 1, 0); PG8_LDB(B1, 1, 1); PG8_SCHED; PG8_LDA(At, 1, 0); PG8_STAGE(PG8_SA(0, 1), a2 + hstepA, voffA);
            PG8_WAIT_V(8); PG8_WAIT_L(0); PG8_BAR; PG8_MMA(0, 0, At, B0); PG8_MMA(0, 1, At, B1); PG8_BAR; PG8_SCHED;
            PG8_LDA(At, 1, 1); PG8_STAGE(PG8_SB(1, 0), b3, voffB); PG8_STAGE(PG8_SB(1, 1), b3 + hstepB, voffB); PG8_STAGE(PG8_SA(1, 0), a3, voffA);
            PG8_WAIT_V(8); PG8_WAIT_L(0); PG8_BAR; PG8_MMA(1, 0, At, B0); PG8_MMA(1, 1, At, B1); PG8_BAR; PG8_SCHED;
        }
        if constexpr (ALIGN_EPI) { if (wr == 0) PG8_BAR; }
        E(acc, cur, wr, wc, fr, fq);
        if (!has_next) break;
        fresh = true;
#pragma unroll
        for (int a = 0; a < 2; ++a)
#pragma unroll
            for (int b = 0; b < 2; ++b)
#pragma unroll
                for (int m = 0; m < 4; ++m)
#pragma unroll
                    for (int n = 0; n < 2; ++n) acc[a][b][m][n] = (f32x4){0.f, 0.f, 0.f, 0.f};
        cur = nxt; cA = nA; cB = nB; ++ui;
        if constexpr (ALIGN_EPI) { if (wr == 1) PG8_BAR; }
    }
    PG8_WAIT_V(0);
    if constexpr (!ALIGN_EPI) { if (wr == 0) PG8_BAR; }
    PG8_BAR;
#undef PG8_SA
#undef PG8_SB
#undef PG8_STAGE
#undef PG8_LDA
#undef PG8_LDB
#undef PG8_MMA
#undef PG8_WAIT_V
#undef PG8_WAIT_L
#undef PG8_BAR
#undef PG8_SCHED
}
#define SEL3(arr, t) ((t) == 0 ? (arr)[0] : (t) == 1 ? (arr)[1] : (arr)[2])
struct EpiPermOnly { static constexpr bool PERM = true, MID = false; };
struct Gemm3 { const bf16_t* A[3]; const bf16_t* Bt[3]; int nt[3]; size_t gsA[3], gsB[3]; int lda, ldb; };
template <class Sched, class E0, class E1, class E2, bool ALIGN_EPI, class Epi = EpiPermOnly>
__device__ __forceinline__ void gemm_phase_multi(LAS unsigned char* lds, const Gemm3 g, const Sched& S, const E0& e0, const E1& e1, const E2& e2, const int wid) {
    static_assert(E0::PERM && E1::PERM && E2::PERM && !E0::MID && !E1::MID && !E2::MID, "multi stream: permuted layout, no mid-K hooks");
    int tid = tid_of(wid); asm volatile("" : "+v"(tid));
    const int lane = tid & 63, wr = wid >> 2, wc = wid & 3; int fr = lane & 15, fq = lane >> 4;
    unsigned voffA[2], voffB[2];
#pragma unroll
    for (int i = 0; i < 2; ++i) { int R, C; stage_rc(tid * 16 + i * 8192, R, C); const int Rb = Epi::PERM ? ((R & ~31) + perm32(R & 31)) : R;
        voffA[i] = (unsigned)(R * g.lda + C) * 2u; voffB[i] = (unsigned)(Rb * g.ldb + C) * 2u; }
    const size_t kstep = (size_t)(BK * 2);
    const size_t hstepA = (size_t)HALF * g.lda * 2, hstepB = (size_t)HALF * g.ldb * 2;
    const size_t tstepA = 2 * hstepA, tstepB = 2 * hstepB;
    const unsigned ldsw = (unsigned)wid * 1024u;
    const int aoff = lds_byte(wr * 64 + fr, fq * 8), boff = lds_byte(wc * 32 + fr, fq * 8);
#define PG8_SA(b, h) (((b) * 2 + (h)) * HTB)
#define PG8_SB(b, h) ((4 + (b) * 2 + (h)) * HTB)
#define PG8_STAGE(bufoff, gbase, voff) do { _Pragma("unroll") for (int _i = 0; _i < 2; ++_i) \
        __builtin_amdgcn_global_load_lds((const unsigned*)((const char*)(gbase) + (voff)[_i]), (LAS unsigned*)(lds + (bufoff) + ldsw + _i * 8192), 16, 0, 0); } while (0)
#define PG8_LDA(dst, b, h) do { _Pragma("unroll") for (int m = 0; m < 4; ++m) _Pragma("unroll") for (int k = 0; k < 2; ++k) dst[m][k] = *(const LAS bf16x8*)(lds + PG8_SA(b, h) + aoff + m * 2048 + k * 1024); } while (0)
#define PG8_LDB(dst, b, h) do { _Pragma("unroll") for (int n = 0; n < 2; ++n) _Pragma("unroll") for (int k = 0; k < 2; ++k) dst[n][k] = *(const LAS bf16x8*)(lds + PG8_SB(b, h) + boff + n * 2048 + k * 1024); } while (0)
#define PG8_MMA(ai, bj, At, Bt) do { __builtin_amdgcn_s_setprio(1); _Pragma("unroll") for (int m = 0; m < 4; ++m) _Pragma("unroll") for (int n = 0; n < 2; ++n) _Pragma("unroll") for (int k = 0; k < 2; ++k) \
        acc[ai][bj][m][n] = __builtin_amdgcn_mfma_f32_16x16x32_bf16(Bt[n][k], At[m][k], acc[ai][bj][m][n], 0, 0, 0); __builtin_amdgcn_s_setprio(0); } while (0)
#define PG8_WAIT_V(n) asm volatile("s_waitcnt vmcnt(" #n ")" ::: "memory")
#define PG8_WAIT_L(n) asm volatile("s_waitcnt lgkmcnt(" #n ")" ::: "memory")
#define PG8_BAR __builtin_amdgcn_s_barrier()
#define PG8_SCHED __builtin_amdgcn_sched_barrier(0)
    Unit cur, nxt; int ui = 0;
    if (!S.next(0, cur)) return;
    cur.ui = 0;
    f32x4 acc[2][2][4][2];
#pragma unroll
    for (int a = 0; a < 2; ++a)
#pragma unroll
        for (int b = 0; b < 2; ++b)
#pragma unroll
            for (int m = 0; m < 4; ++m)
#pragma unroll
                for (int n = 0; n < 2; ++n) acc[a][b][m][n] = (f32x4){0.f, 0.f, 0.f, 0.f};
    bf16x8 At[4][2], B0[2][2], B1[2][2];
    bool fresh = false;
    const char* cA = (const char*)SEL3(g.A, cur.ty) + ((size_t)cur.pg * SEL3(g.gsA, cur.ty)) * 2 + (size_t)cur.pm * tstepA; const char* cB = (const char*)SEL3(g.Bt, cur.ty) + ((size_t)cur.pg * SEL3(g.gsB, cur.ty)) * 2 + (size_t)cur.pn * tstepB;
    int nt = SEL3(g.nt, cur.ty);
    PG8_STAGE(PG8_SB(0, 0), cB, voffB); PG8_STAGE(PG8_SB(0, 1), cB + hstepB, voffB); PG8_STAGE(PG8_SA(0, 0), cA, voffA); PG8_STAGE(PG8_SA(0, 1), cA + hstepA, voffA);
    if (wr == 1) PG8_BAR;
    PG8_WAIT_V(2); PG8_BAR;
    PG8_STAGE(PG8_SB(1, 0), cB + kstep, voffB); PG8_STAGE(PG8_SA(1, 0), cA + kstep, voffA); PG8_STAGE(PG8_SB(1, 1), cB + hstepB + kstep, voffB);
    PG8_WAIT_V(6); PG8_BAR;
    for (;;) {
        const bool has_next = S.next(ui + 1, nxt); nxt.ui = ui + 1;
        const char* nA = has_next ? (const char*)SEL3(g.A, nxt.ty) + ((size_t)nxt.pg * SEL3(g.gsA, nxt.ty)) * 2 + (size_t)nxt.pm * tstepA : cA;
        const char* nB = has_next ? (const char*)SEL3(g.Bt, nxt.ty) + ((size_t)nxt.pg * SEL3(g.gsB, nxt.ty)) * 2 + (size_t)nxt.pn * tstepB : cB;
#pragma unroll 1
        for (int t = 0; t < nt; t += 2) {
            const bool last = (t == nt - 2);
            const char* a1 = cA + (size_t)(t + 1) * kstep;
            const char* a2 = last ? nA : cA + (size_t)(t + 2) * kstep; const char* b2 = last ? nB : cB + (size_t)(t + 2) * kstep;
            const char* a3 = a2 + kstep; const char* b3 = b2 + kstep;
            PG8_LDB(B0, 0, 0); PG8_LDB(B1, 0, 1); PG8_SCHED; PG8_LDA(At, 0, 0); PG8_STAGE(PG8_SA(1, 1), a1 + hstepA, voffA);
            if (!fresh) PG8_WAIT_V(8); PG8_WAIT_L(0); PG8_BAR; PG8_MMA(0, 0, At, B0); PG8_MMA(0, 1, At, B1); PG8_BAR; PG8_SCHED;
            PG8_LDA(At, 0, 1); PG8_STAGE(PG8_SB(0, 0), b2, voffB); PG8_STAGE(PG8_SB(0, 1), b2 + hstepB, voffB); PG8_STAGE(PG8_SA(0, 0), a2, voffA);
            PG8_WAIT_V(8); PG8_WAIT_L(0); PG8_BAR; PG8_MMA(1, 0, At, B0); PG8_MMA(1, 1, At, B1); PG8_BAR; PG8_SCHED;
            fresh = false;
            PG8_LDB(B0, 1, 0); PG8_LDB(B1, 1, 1); PG8_SCHED; PG8_LDA(At, 1, 0); PG8_STAGE(PG8_SA(0, 1), a2 + hstepA, voffA);
            PG8_WAIT_V(8); PG8_WAIT_L(0); PG8_BAR; PG8_MMA(0, 0, At, B0); PG8_MMA(0, 1, At, B1); PG8_BAR; PG8_SCHED;
            PG8_LDA(At, 1, 1); PG8_STAGE(PG8_SB(1, 0), b3, voffB); PG8_STAGE(PG8_SB(1, 1), b3 + hstepB, voffB); PG8_STAGE(PG8_SA(1, 0), a3, voffA);
            PG8_WAIT_V(8); PG8_WAIT_L(0); PG8_BAR; PG8_MMA(1, 0, At, B0); PG8_MMA(1, 1, At, B1); PG8_BAR; PG8_SCHED;
        }
        if constexpr (ALIGN_EPI) { if (wr == 0) PG8_BAR; }
        if (cur.ty == 0) e0(acc, cur, wr, wc, fr, fq); else if (cur.ty == 1) e1(acc, cur, wr, wc, fr, fq); else e2(acc, cur, wr, wc, fr, fq);
        if (!has_next) break;
        fresh = true;
#pragma unroll
        for (int a = 0; a < 2; ++a)
#pragma unroll
            for (int b = 0; b < 2; ++b)
#pragma unroll
                for (int m = 0; m < 4; ++m)
#pragma unroll
                    for (int n = 0; n < 2; ++n) acc[a][b][m][n] = (f32x4){0.f, 0.f, 0.f, 0.f};
        cur = nxt; cA = nA; cB = nB; ++ui; nt = SEL3(g.nt, cur.ty);
        if constexpr (ALIGN_EPI) { if (wr == 1) PG8_BAR; }
    }
    PG8_WAIT_V(0);
    if constexpr (!ALIGN_EPI) { if (wr == 0) PG8_BAR; }
    PG8_BAR;
#undef PG8_SA
#undef PG8_SB
#undef PG8_STAGE
#undef PG8_LDA
#undef PG8_LDB
#undef PG8_MMA
#undef PG8_WAIT_V
#undef PG8_WAIT_L
#undef PG8_BAR
#undef PG8_SCHED
}
}
using pg8::Unit;
typedef f32x4 Acc[2][2][4][2];

__device__ __forceinline__ int kvrow_of(int row) { return (row >> 13) * KVR + (row & 8191); }

struct EpiProj {
    static constexpr bool PERM = true, MID = false;
    bf16_t *CQ, *UP, *KR; float *PART, *UM; const float* TAB; const LAS float* rt;
    __device__ __forceinline__ void operator()(const Acc& acc, const Unit& u, int wr, int wc, int fr, int fq) const {
        asm volatile("" : "+v"(fr), "+v"(fq));
#pragma unroll
        for (int bj = 0; bj < 2; ++bj) {
            const int gidx = u.pn * 8 + bj * 4 + wc;
            if (gidx >= 37) continue;
#pragma unroll
            for (int ai = 0; ai < 2; ++ai)
#pragma unroll
                for (int m = 0; m < 4; ++m) {
                    const int row = u.pm * 256 + ai * 128 + wr * 64 + m * 16 + fr;
                    const bool meta = row >= MX; const int j = row - MX; const bool ok = !meta || j < NMETA;
                    const float rs_ = rt[u.ui * 256 + ai * 128 + wr * 64 + m * 16 + fr];
                    const f32x4 v0 = acc[ai][bj][m][0] * rs_, v1 = acc[ai][bj][m][1] * rs_;
                    if (gidx < 20) {
                        float ss = (v0[0] * v0[0] + v0[1] * v0[1]) + (v0[2] * v0[2] + v0[3] * v0[3]) + (v1[0] * v1[0] + v1[1] * v1[1]) + (v1[2] * v1[2] + v1[3] * v1[3]);
                        ss += __shfl_xor(ss, 16); ss += __shfl_xor(ss, 32);
                        if (ok) {
                            bf16_t* dst = CQ + (size_t)row * 768 + gidx * 32 + 8 * fq;
                            *(u32x4*)dst = pack8(v0, v1);
                            if (fq == 0) PART[(size_t)row * 20 + gidx] = ss;
                        }
                    } else if (gidx < 36) {
                        const int ch0 = (gidx - 20) * 32 + 8 * fq;
                        if (!meta) { const int g = ch0 >> 4, h0 = ch0 & 15, n = row >> 5, i = row & 31;
                            *(u32x4*)(UP + ((size_t)(g * NCH + n) * 768 + i * 16 + h0)) = pack8(v0, v1);
                        } else if (ok) { float* d = UM + j * 512 + ch0; *(f32x4*)d = v0; *(f32x4*)(d + 4) = v1; }
                    } else {
                        if (ok) {
                            const f32x4 cs = *(const f32x4*)(TAB + (size_t)row * 32 + 4 * fq), sn = *(const f32x4*)(TAB + (size_t)row * 32 + 16 + 4 * fq);
                            f32x4 o0, o1;
                            o0[0] = v0[0] * cs[0] - v0[1] * sn[0]; o0[1] = v0[0] * sn[0] + v0[1] * cs[0];
                            o0[2] = v0[2] * cs[1] - v0[3] * sn[1]; o0[3] = v0[2] * sn[1] + v0[3] * cs[1];
                            o1[0] = v1[0] * cs[2] - v1[1] * sn[2]; o1[1] = v1[0] * sn[2] + v1[1] * cs[2];
                            o1[2] = v1[2] * cs[3] - v1[3] * sn[3]; o1[3] = v1[2] * sn[3] + v1[3] * cs[3];
                            const u32x4 w = pack8(o0, o1);
                            if (!meta) *(u32x4*)(KR + (size_t)kvrow_of(row) * 32 + 8 * fq) = w;
                            else {
#pragma unroll
                                for (int b = 0; b < NB; ++b) *(u32x4*)(KR + (size_t)(b * KVR + SEQ + j) * 32 + 8 * fq) = w; }
                        }
                    }
                }
        }
    }
};
__device__ __forceinline__ float rstd_from(const float* p, int cnt4, float inv_n) {
    float s = 0.f;
    for (int i = 0; i < cnt4; ++i) { const f32x4 v = *(const f32x4*)(p + 4 * i); s += (v[0] + v[1]) + (v[2] + v[3]); }
    return __builtin_amdgcn_rsqf(s * inv_n + EPS);
}
struct EpiQ {
    static constexpr bool PERM = true, MID = false;
    bf16_t* Q; const LAS f32x2* tab; const float* TAB;
    __device__ __forceinline__ void operator()(const Acc& acc, const Unit& u, int wr, int wc, int fr, int fq) const {
        asm volatile("" : "+v"(fr), "+v"(fq));
#pragma unroll
        for (int ai = 0; ai < 2; ++ai)
#pragma unroll
            for (int m = 0; m < 4; ++m) {
                const int rl = ai * 128 + wr * 64 + m * 16 + fr, row = u.pm * 256 + rl;
                const float sc = tab[u.ui * 256 + rl][0];
#pragma unroll
                for (int bj = 0; bj < 2; ++bj) {
                    const int gidx = u.pn * 8 + bj * 4 + wc;
                    f32x4 v0 = acc[ai][bj][m][0] * sc, v1 = acc[ai][bj][m][1] * sc;
                    if (gidx % 3 == 2) {
                        const f32x4 cs = *(const f32x4*)(TAB + (size_t)row * 32 + 4 * fq), sn = *(const f32x4*)(TAB + (size_t)row * 32 + 16 + 4 * fq);
                        f32x4 o0, o1;
                        o0[0] = v0[0] * cs[0] - v0[1] * sn[0]; o0[1] = v0[0] * sn[0] + v0[1] * cs[0];
                        o0[2] = v0[2] * cs[1] - v0[3] * sn[1]; o0[3] = v0[2] * sn[1] + v0[3] * cs[1];
                        o1[0] = v1[0] * cs[2] - v1[1] * sn[2]; o1[1] = v1[0] * sn[2] + v1[1] * cs[2];
                        o1[2] = v1[2] * cs[3] - v1[3] * sn[3]; o1[3] = v1[2] * sn[3] + v1[3] * cs[3];
                        v0 = o0; v1 = o1;
                    }
                    *(u32x4*)(Q + (size_t)row * 768 + gidx * 32 + 8 * fq) = pack8(v0, v1);
                }
                asm volatile("" ::: "memory");
            }
    }
};
struct EpiKV {
    static constexpr bool PERM = true, MID = false;
    bf16_t *KN, *VV; const LAS f32x2* tab;
    __device__ __forceinline__ void operator()(const Acc& acc, const Unit& u, int wr, int wc, int fr, int fq) const {
        asm volatile("" : "+v"(fr), "+v"(fq));
#pragma unroll
        for (int ai = 0; ai < 2; ++ai)
#pragma unroll
            for (int m = 0; m < 4; ++m) {
                const int rl = ai * 128 + wr * 64 + m * 16 + fr, row = u.pm * 256 + rl;
                const bool meta = row >= MX; const int j = row - MX; if (meta && j >= NMETA) continue;
                const float sc = tab[u.ui * 256 + rl][0];
#pragma unroll
                for (int bj = 0; bj < 2; ++bj) {
                    const int gidx = u.pn * 8 + bj * 4 + wc;
                    const u32x4 w = pack8(acc[ai][bj][m][0] * sc, acc[ai][bj][m][1] * sc);
                    bf16_t* base = gidx < 16 ? KN : VV; const int col = (gidx & 15) * 32 + 8 * fq;
                    if (!meta) *(u32x4*)(base + (size_t)kvrow_of(row) * 512 + col) = w;
                    else {
#pragma unroll
                        for (int b = 0; b < NB; ++b) *(u32x4*)(base + (size_t)(b * KVR + SEQ + j) * 512 + col) = w; }
                }
                asm volatile("" ::: "memory");
            }
    }
};
struct EpiState {
    static constexpr bool PERM = true, MID = false;
    float* S;
    __device__ __forceinline__ void operator()(const Acc& acc, const Unit& u, int wr, int wc, int fr, int fq) const {
        asm volatile("" : "+v"(fr), "+v"(fq));
#pragma unroll
        for (int ai = 0; ai < 2; ++ai)
#pragma unroll
            for (int m = 0; m < 4; ++m) {
                const int row = u.pm * 256 + ai * 128 + wr * 64 + m * 16 + fr;
                float* d = S + ((size_t)u.pg * NCH + row) * 256 + wc * 32 + 8 * fq;
#pragma unroll
                for (int bj = 0; bj < 2; ++bj)
#pragma unroll
                    for (int n = 0; n < 2; ++n) *(f32x4*)(d + bj * 128 + n * 4) = acc[ai][bj][m][n];
            }
    }
};
__device__ __forceinline__ float gelu_tanh(float v) {
    const float t = v * (1.0f + 0.044715f * v * v) * (-2.0f * 0.7978845608028654f * 1.4426950408889634f);
    return v * __builtin_amdgcn_rcpf(1.0f + __builtin_amdgcn_exp2f(t));
}
struct EpiY {
    static constexpr bool PERM = true, MID = false;
    bf16_t* Y;
    __device__ __forceinline__ void operator()(const Acc& acc, const Unit& u, int wr, int wc, int fr, int fq) const {
        asm volatile("" : "+v"(fr), "+v"(fq));
#pragma unroll
        for (int ai = 0; ai < 2; ++ai)
#pragma unroll
            for (int m = 0; m < 4; ++m) {
                const int n = u.pm * 256 + ai * 128 + wr * 64 + m * 16 + fr;
#pragma unroll
                for (int bj = 0; bj < 2; ++bj) {
                    const int c = u.pn * 256 + bj * 128 + wc * 32 + 8 * fq, i = c >> 4, h0 = c & 15;
                    f32x4 v0 = acc[ai][bj][m][0], v1 = acc[ai][bj][m][1];
#pragma unroll
                    for (int e = 0; e < 4; ++e) { v0[e] = gelu_tanh(v0[e]); v1[e] = gelu_tanh(v1[e]); }
                    *(u32x4*)(Y + (size_t)(n * 32 + i) * 512 + u.pg * 16 + h0) = pack8(v0, v1);
                }
            }
    }
};
struct EpiGLU {
    static constexpr bool PERM = true, MID = false;
    bf16_t* MIX; float* PARTS;
    __device__ __forceinline__ void operator()(const Acc& acc, const Unit& u, int wr, int wc, int fr, int fq) const {
        asm volatile("" : "+v"(fr), "+v"(fq));
#pragma unroll
        for (int ai = 0; ai < 2; ++ai)
#pragma unroll
            for (int m = 0; m < 4; ++m) {
                const int row = u.pm * 256 + ai * 128 + wr * 64 + m * 16 + fr;
                f32x4 o[2]; float ss = 0.f;
#pragma unroll
                for (int n = 0; n < 2; ++n) { const f32x4 z1 = acc[ai][0][m][n], z2 = acc[ai][1][m][n];
#pragma unroll
                    for (int e = 0; e < 4; ++e) o[n][e] = z1[e] * __builtin_amdgcn_rcpf(1.0f + __builtin_amdgcn_exp2f(-1.4426950408889634f * z2[e]));
                    ss += (o[n][0] * o[n][0] + o[n][1] * o[n][1]) + (o[n][2] * o[n][2] + o[n][3] * o[n][3]); }
                ss += __shfl_xor(ss, 16); ss += __shfl_xor(ss, 32);
                *(u32x4*)(MIX + (size_t)row * 1024 + 512 + u.pn * 128 + wc * 32 + 8 * fq) = pack8(o[0], o[1]);
                if (fq == 0) PARTS[(size_t)row * 16 + u.pn * 4 + wc] = ss;
            }
    }
};
struct EpiWout {
    static constexpr bool PERM = false, MID = true;
    float* V1; const LAS f32x2* tab;
    __device__ __forceinline__ void mid(Acc& acc, const Unit& u, int wr, int wc, int fr, int fq) const {
        asm volatile("" : "+v"(fr), "+v"(fq));
#pragma unroll
        for (int ai = 0; ai < 2; ++ai)
#pragma unroll
            for (int m = 0; m < 4; ++m) {
                const int rl = ai * 128 + wr * 64 + m * 16 + fr;
                const float f = tab[u.ui * 256 + rl][0];
#pragma unroll
                for (int bj = 0; bj < 2; ++bj)
#pragma unroll
                    for (int n = 0; n < 2; ++n) acc[ai][bj][m][n] *= f;
                asm volatile("" ::: "memory");
            }
    }
    __device__ __forceinline__ void operator()(const Acc& acc, const Unit& u, int wr, int wc, int fr, int fq) const {
        asm volatile("" : "+v"(fr), "+v"(fq));
#pragma unroll
        for (int ai = 0; ai < 2; ++ai)
#pragma unroll
            for (int m = 0; m < 4; ++m) {
                const int rl = ai * 128 + wr * 64 + m * 16 + fr, row = u.pm * 256 + rl;
                const float rs = tab[u.ui * 256 + rl][1];
                float* d = V1 + (size_t)row * 1024 + u.pn * 256 + wc * 32 + 4 * fq;
#pragma unroll
                for (int bj = 0; bj < 2; ++bj)
#pragma unroll
                    for (int n = 0; n < 2; ++n) *(f32x4*)(d + bj * 128 + n * 16) = acc[ai][bj][m][n] * rs;
                asm volatile("" ::: "memory");
            }
    }
};
struct EpiRelu2 {
    static constexpr bool PERM = true, MID = false;
    bf16_t* H; const LAS float* tabf;
    __device__ __forceinline__ void operator()(const Acc& acc, const Unit& u, int wr, int wc, int fr, int fq) const {
        asm volatile("" : "+v"(fr), "+v"(fq));
#pragma unroll
        for (int ai = 0; ai < 2; ++ai)
#pragma unroll
            for (int m = 0; m < 4; ++m) {
                const int rl = ai * 128 + wr * 64 + m * 16 + fr, row = u.pm * 256 + rl;
                const float s2 = tabf[u.ui * 256 + rl];
#pragma unroll
                for (int bj = 0; bj < 2; ++bj) {
                    f32x4 v0 = acc[ai][bj][m][0], v1 = acc[ai][bj][m][1];
#pragma unroll
                    for (int e = 0; e < 4; ++e) { const float a = fmaxf(v0[e], 0.f), b = fmaxf(v1[e], 0.f); v0[e] = a * a * s2; v1[e] = b * b * s2; }
                    *(u32x4*)(H + (size_t)row * DFF + u.pn * 256 + bj * 128 + wc * 32 + 8 * fq) = pack8(v0, v1);
                }
            }
    }
};
struct EpiF32 {
    static constexpr bool PERM = false, MID = false;
    float* O;
    __device__ __forceinline__ void operator()(const Acc& acc, const Unit& u, int wr, int wc, int fr, int fq) const {
        asm volatile("" : "+v"(fr), "+v"(fq));
#pragma unroll
        for (int ai = 0; ai < 2; ++ai)
#pragma unroll
            for (int m = 0; m < 4; ++m) {
                const int row = u.pm * 256 + ai * 128 + wr * 64 + m * 16 + fr;
                float* d = O + (size_t)row * 1024 + u.pn * 256 + wc * 32 + 4 * fq;
#pragma unroll
                for (int bj = 0; bj < 2; ++bj)
#pragma unroll
                    for (int n = 0; n < 2; ++n) *(f32x4*)(d + bj * 128 + n * 16) = acc[ai][bj][m][n];
            }
    }
};

#define RLX_AGENT __ATOMIC_RELAXED, __HIP_MEMORY_SCOPE_AGENT
constexpr size_t WS_CNT = 128 * 1024;
constexpr size_t WS_XB = 488 * (size_t)(1u << 20);
struct PanelRms {
    float* xbuf; unsigned* cnt; unsigned* tmo;
    __device__ __forceinline__ void run(const Acc& v, const Unit& u, int wr, int wc, int fr, int fq, LAS unsigned char* tl) const {
        LAS float* P = (LAS float*)tl; LAS float* S = (LAS float*)(tl + 4096);
        const int wid = wr * 4 + wc, lane = fq * 16 + fr;
#pragma unroll
        for (int ai = 0; ai < 2; ++ai)
#pragma unroll
            for (int m = 0; m < 4; ++m) {
                float s = 0.f;
#pragma unroll
                for (int bj = 0; bj < 2; ++bj)
#pragma unroll
                    for (int n = 0; n < 2; ++n) { const f32x4 x = v[ai][bj][m][n]; s += (x[0] * x[0] + x[1] * x[1]) + (x[2] * x[2] + x[3] * x[3]); }
                s += __shfl_xor(s, 16); s += __shfl_xor(s, 32);
                if (fq == 0) P[(ai * 128 + wr * 64 + m * 16 + fr) * 4 + wc] = s;
            }
        asm volatile("s_waitcnt lgkmcnt(0)" ::: "memory"); __builtin_amdgcn_s_barrier(); asm volatile("" ::: "memory");
        const int row = wid * 32 + (lane & 31);
        if (lane < 32) {
            const float t = (P[row * 4 + 0] + P[row * 4 + 1]) + (P[row * 4 + 2] + P[row * 4 + 3]);
            __hip_atomic_store(xbuf + ((size_t)(u.pm * 256 + row) * 4 + u.pn), t, RLX_AGENT);
        }
        asm volatile("s_waitcnt vmcnt(0)" ::: "memory");
        if (lane == 0) __hip_atomic_fetch_add(cnt + 64 * u.pm, 1u, RLX_AGENT);
        if (wid == 0) {
            unsigned sp = 0;
            for (;;) {
                if ((unsigned)__builtin_amdgcn_readfirstlane(__hip_atomic_load(cnt + 64 * u.pm, RLX_AGENT)) >= 32u) break;
                if (++sp > (1u << 22)) { if (lane == 0) __hip_atomic_store(tmo, 1u, RLX_AGENT); break; }
                __builtin_amdgcn_s_sleep(1);
            }
        }
        asm volatile("s_waitcnt vmcnt(0) lgkmcnt(0)" ::: "memory"); __builtin_amdgcn_s_barrier(); asm volatile("" ::: "memory");
        if (lane < 32) {
            const float* slot = xbuf + (size_t)(u.pm * 256 + row) * 4; float t = 0.f;
#pragma unroll
            for (int k = 0; k < 4; ++k) t += __hip_atomic_load(slot + k, RLX_AGENT);
            S[row] = __builtin_amdgcn_rsqf(t * (1.0f / 1024.0f) + EPS);
        }
        asm volatile("s_waitcnt lgkmcnt(0)" ::: "memory"); __builtin_amdgcn_s_barrier(); asm volatile("" ::: "memory");
    }
};
struct EpiWoutLN {
    static constexpr bool PERM = true, MID = true;
    const bf16_t* xb; bf16_t* H1B; float* PARTH; const float* g1; const LAS f32x2* tab; LAS unsigned char* tl; PanelRms st1;
    __device__ __forceinline__ void mid(Acc& acc, const Unit& u, int wr, int wc, int fr, int fq) const {
        asm volatile("" : "+v"(fr), "+v"(fq));
#pragma unroll
        for (int ai = 0; ai < 2; ++ai)
#pragma unroll
            for (int m = 0; m < 4; ++m) {
                const int rl = ai * 128 + wr * 64 + m * 16 + fr;
                const float f = tab[u.ui * 256 + rl][0];
#pragma unroll
                for (int bj = 0; bj < 2; ++bj)
#pragma unroll
                    for (int n = 0; n < 2; ++n) acc[ai][bj][m][n] *= f;
            }
    }
    __device__ __forceinline__ void operator()(Acc& acc, const Unit& u, int wr, int wc, int fr, int fq) const {
        asm volatile("" : "+v"(fr), "+v"(fq));
        const LAS float* S = (const LAS float*)(tl + 4096);
#pragma unroll
        for (int ai = 0; ai < 2; ++ai)
#pragma unroll
            for (int m = 0; m < 4; ++m) { const float rs = tab[u.ui * 256 + ai * 128 + wr * 64 + m * 16 + fr][1];
#pragma unroll
                for (int bj = 0; bj < 2; ++bj)
#pragma unroll
                    for (int n = 0; n < 2; ++n) acc[ai][bj][m][n] *= rs; }
        const int col0 = u.pn * 256 + wc * 32 + 8 * fq;
        u32x4 xr_[2][4][2];
#define XR_LD(ai_, m_) do { const size_t off_ = (size_t)(u.pm * 256 + (ai_) * 128 + wr * 64 + (m_) * 16 + fr) * 1024 + col0; \
            xr_[ai_][m_][0] = *(const u32x4*)(xb + off_); xr_[ai_][m_][1] = *(const u32x4*)(xb + off_ + 128); } while (0)
        XR_LD(0, 0); XR_LD(0, 1); XR_LD(0, 2); XR_LD(0, 3); XR_LD(1, 0); XR_LD(1, 1);
        st1.run(acc, u, wr, wc, fr, fq, tl);
        XR_LD(1, 2); XR_LD(1, 3);
#undef XR_LD
#pragma unroll
        for (int ai = 0; ai < 2; ++ai) {
#pragma unroll
            for (int m = 0; m < 4; ++m) { const int rl = ai * 128 + wr * 64 + m * 16 + fr, row = u.pm * 256 + rl; const float r1 = S[rl]; const size_t off = (size_t)row * 1024 + col0;
#pragma unroll
                for (int bj = 0; bj < 2; ++bj) {
                    const f32x4 g0 = *(const f32x4*)(g1 + col0 + bj * 128), g4 = *(const f32x4*)(g1 + col0 + bj * 128 + 4);
                    const u32x4 xw = xr_[ai][m][bj]; f32x4 x0, x4;
                    x0[0] = __uint_as_float(xw.x << 16); x0[1] = __uint_as_float(xw.x & 0xffff0000u); x0[2] = __uint_as_float(xw.y << 16); x0[3] = __uint_as_float(xw.y & 0xffff0000u);
                    x4[0] = __uint_as_float(xw.z << 16); x4[1] = __uint_as_float(xw.z & 0xffff0000u); x4[2] = __uint_as_float(xw.w << 16); x4[3] = __uint_as_float(xw.w & 0xffff0000u);
                    const f32x4 h0 = x0 + acc[ai][bj][m][0] * r1 * g0, h4 = x4 + acc[ai][bj][m][1] * r1 * g4;
                    float ss = (h0[0] * h0[0] + h0[1] * h0[1]) + (h0[2] * h0[2] + h0[3] * h0[3]) + (h4[0] * h4[0] + h4[1] * h4[1]) + (h4[2] * h4[2] + h4[3] * h4[3]);
                    *(u32x4*)(H1B + off + bj * 128) = pack8(h0, h4);
                    ss += __shfl_xor(ss, 16); ss += __shfl_xor(ss, 32);
                    if (fq == 0) PARTH[(size_t)row * 32 + u.pn * 8 + bj * 4 + wc] = ss; }
                if (m & 1) asm volatile("" ::: "memory"); }
        }
    }
};
struct EpiDownLN {
    static constexpr bool PERM = true, MID = false;
    float* out; const bf16_t* H1B; const float* g; LAS unsigned char* tl; PanelRms st;
    __device__ __forceinline__ void operator()(Acc& acc, const Unit& u, int wr, int wc, int fr, int fq) const {
        asm volatile("" : "+v"(fr), "+v"(fq));
        const LAS float* S = (const LAS float*)(tl + 4096);
        const int col0 = u.pn * 256 + wc * 32 + 8 * fq;
        u32x4 pre[2][4][2];
#define HR_LD(ai_, m_) do { const size_t off_ = (size_t)(u.pm * 256 + (ai_) * 128 + wr * 64 + (m_) * 16 + fr) * 1024 + col0; \
            pre[ai_][m_][0] = *(const u32x4*)(H1B + off_); pre[ai_][m_][1] = *(const u32x4*)(H1B + off_ + 128); } while (0)
        HR_LD(0, 0); HR_LD(0, 1); HR_LD(0, 2); HR_LD(0, 3); HR_LD(1, 0); HR_LD(1, 1);
        st.run(acc, u, wr, wc, fr, fq, tl);
        HR_LD(1, 2); HR_LD(1, 3);
#undef HR_LD
#pragma unroll
        for (int ai = 0; ai < 2; ++ai) {
#pragma unroll
            for (int m = 0; m < 4; ++m) { const int rl = ai * 128 + wr * 64 + m * 16 + fr; const float r = S[rl]; const size_t off = (size_t)(u.pm * 256 + rl) * 1024 + col0;
#pragma unroll
                for (int bj = 0; bj < 2; ++bj) {
                    const f32x4 g0 = *(const f32x4*)(g + col0 + bj * 128), g4 = *(const f32x4*)(g + col0 + bj * 128 + 4);
                    const u32x4 hb = pre[ai][m][bj];
                    f32x4 h0, h4;
                    h0[0] = __uint_as_float(hb.x << 16); h0[1] = __uint_as_float(hb.x & 0xffff0000u); h0[2] = __uint_as_float(hb.y << 16); h0[3] = __uint_as_float(hb.y & 0xffff0000u);
                    h4[0] = __uint_as_float(hb.z << 16); h4[1] = __uint_as_float(hb.z & 0xffff0000u); h4[2] = __uint_as_float(hb.w << 16); h4[3] = __uint_as_float(hb.w & 0xffff0000u);
                    *(f32x4*)(out + off + bj * 128) = h0 + acc[ai][bj][m][0] * r * g0;
                    *(f32x4*)(out + off + bj * 128 + 4) = h4 + acc[ai][bj][m][1] * r * g4; }
                if (m & 1) asm volatile("" ::: "memory"); }
        }
    }
};

namespace attn {
constexpr int NW = 8, QBLK = 32, KVBLK = 64, NT = KVR / KVBLK;
constexpr int SHM_K = KVBLK * 96 * 2, SHM_V = KVBLK * 64 * 2;
constexpr int OFF_V = 0, OFF_K = 3 * SHM_V, OFF_WS = OFF_K + 3 * SHM_K, OFF_OST = OFF_WS + NW * 64 * 4, OST_WAVE = 32 * 272, LDS_END = OFF_OST + NW * OST_WAVE;
constexpr float THR = 11.5f;
#define SBAR() __builtin_amdgcn_sched_barrier(0)
__device__ __forceinline__ int crow(int r, int hi) { return (r & 3) + 8 * (r >> 2) + 4 * hi; }
template <bool FIRST> __device__ __forceinline__ void rowcheck(f32x16& p0, f32x16& p1, float& mhat, f32x16& negm, float& alpha) {
    float a = __builtin_fmaxf(__builtin_fmaxf(p0[0], p0[1]), p1[0]), b = __builtin_fmaxf(__builtin_fmaxf(p0[2], p0[3]), p1[1]); a = __builtin_fmaxf(__builtin_fmaxf(a, p1[2]), p1[3]);
#pragma unroll
    for (int r = 4; r < 16; r += 4) { a = __builtin_fmaxf(__builtin_fmaxf(a, p0[r]), p0[r + 1]); b = __builtin_fmaxf(__builtin_fmaxf(b, p0[r + 2]), p0[r + 3]);
        a = __builtin_fmaxf(__builtin_fmaxf(a, p1[r]), p1[r + 1]); b = __builtin_fmaxf(__builtin_fmaxf(b, p1[r + 2]), p1[r + 3]); }
    float rm = __builtin_fmaxf(a, b);
    { auto rr = __builtin_amdgcn_permlane32_swap(__float_as_uint(rm), __float_as_uint(rm), false, false); rm = __builtin_fmaxf(__uint_as_float(rr[0]), __uint_as_float(rr[1])); }
    alpha = 1.f;
    if (FIRST || __builtin_expect(__any(rm > THR), 0)) {
        const float dl = FIRST ? rm : __builtin_fmaxf(rm, 0.f); mhat += dl;
#pragma unroll
        for (int r = 0; r < 16; ++r) { p0[r] -= dl; p1[r] -= dl; }
#pragma unroll
        for (int r = 0; r < 16; ++r) negm[r] = -mhat;
        asm volatile("" : "+v"(negm));
        alpha = __builtin_amdgcn_exp2f(-dl);
    }
}
__device__ __forceinline__ void exp16(f32x16& p) {
#pragma unroll
    for (int r = 0; r < 16; ++r) p[r] = __builtin_amdgcn_exp2f(p[r]);
}
__device__ __forceinline__ void packP(const f32x16& p0, const f32x16& p1, bf16x8& pa0, bf16x8& pa1, bf16x8& pa2, bf16x8& pa3) {
#define PK4(P, BASE, OUT) do { u32x4 w = {cvt_pk_bf16(P[BASE + 0], P[BASE + 1]), cvt_pk_bf16(P[BASE + 2], P[BASE + 3]), cvt_pk_bf16(P[BASE + 4], P[BASE + 5]), cvt_pk_bf16(P[BASE + 6], P[BASE + 7])}; \
    OUT = *reinterpret_cast<bf16x8*>(&w); } while (0)
    PK4(p0, 0, pa0); PK4(p0, 8, pa1); PK4(p1, 0, pa2); PK4(p1, 8, pa3);
#undef PK4
}
__device__ __forceinline__ void qkt(f32x16& p0, f32x16& p1, const char* Ks, const int* kx, const bf16x8* qr, const f32x16& negm) {
#pragma unroll
    for (int d0 = 0; d0 < 6; ++d0) { const char* a = Ks + d0 * 2048 + kx[d0 & 3];
        const bf16x8 b0 = *reinterpret_cast<const bf16x8*>(a), b1 = *reinterpret_cast<const bf16x8*>(a + 512);
        if (d0 == 0) { p0 = __builtin_amdgcn_mfma_f32_32x32x16_bf16(b0, qr[0], negm, 0, 0, 0); p1 = __builtin_amdgcn_mfma_f32_32x32x16_bf16(b1, qr[0], negm, 0, 0, 0); }
        else { p0 = __builtin_amdgcn_mfma_f32_32x32x16_bf16(b0, qr[d0], p0, 0, 0, 0); p1 = __builtin_amdgcn_mfma_f32_32x32x16_bf16(b1, qr[d0], p1, 0, 0, 0); }
    }
}
__device__ __forceinline__ int v_st(int k, int c) { const int kk = (k & ~0xC) | ((k & 4) << 1) | ((k & 8) >> 1); return ((kk >> 3) * 2 + (c >> 5)) * 512 + ((kk & 7) * 32 + (c & 31)) * 2; }
__device__ __forceinline__ int v_rd_base(int lane) { return ((lane & 3) << 3) | (((lane >> 2) & 3) << 6) | (((lane >> 4) & 1) << 5) | (((lane >> 5) & 1) << 8); }
constexpr int v_rd_off(int d0, int ks, int half) { return d0 * 512 + ks * 2048 + half * 1024; }
template <int OFF> __device__ __forceinline__ s16x4 tr_read(int vb) {
    s16x4 r; asm volatile("ds_read_b64_tr_b16 %0, %1 offset:%2" : "=&v"(r) : "v"(vb), "i"(OFF) : "memory"); return r;
}
#define PKV(L, H) (bf16x8){L[0], L[1], L[2], L[3], H[0], H[1], H[2], H[3]}
template <int D0> __device__ __forceinline__ void pv_half(f32x16& od, int vb, bf16x8 pa0, bf16x8 pa1, bf16x8 pa2, bf16x8 pa3) {
    const s16x4 a0 = tr_read<v_rd_off(D0, 0, 0)>(vb), b0 = tr_read<v_rd_off(D0, 0, 1)>(vb), a1 = tr_read<v_rd_off(D0, 1, 0)>(vb), b1 = tr_read<v_rd_off(D0, 1, 1)>(vb);
    const s16x4 a2 = tr_read<v_rd_off(D0, 2, 0)>(vb), b2 = tr_read<v_rd_off(D0, 2, 1)>(vb), a3 = tr_read<v_rd_off(D0, 3, 0)>(vb), b3 = tr_read<v_rd_off(D0, 3, 1)>(vb);
    asm volatile("s_waitcnt lgkmcnt(0)" ::: "memory"); SBAR();
    od = __builtin_amdgcn_mfma_f32_32x32x16_bf16(pa0, PKV(a0, b0), od, 0, 0, 0);
    od = __builtin_amdgcn_mfma_f32_32x32x16_bf16(pa1, PKV(a1, b1), od, 0, 0, 0);
    od = __builtin_amdgcn_mfma_f32_32x32x16_bf16(pa2, PKV(a2, b2), od, 0, 0, 0);
    od = __builtin_amdgcn_mfma_f32_32x32x16_bf16(pa3, PKV(a3, b3), od, 0, 0, 0);
}
__device__ __forceinline__ void pv_all(f32x16* o, f32x4& osum, bf16x8 ones, int vb, bf16x8 pa0, bf16x8 pa1, bf16x8 pa2, bf16x8 pa3) {
    osum = __builtin_amdgcn_mfma_f32_16x16x32_bf16(pa0, ones, osum, 0, 0, 0); osum = __builtin_amdgcn_mfma_f32_16x16x32_bf16(pa1, ones, osum, 0, 0, 0);
    osum = __builtin_amdgcn_mfma_f32_16x16x32_bf16(pa2, ones, osum, 0, 0, 0); osum = __builtin_amdgcn_mfma_f32_16x16x32_bf16(pa3, ones, osum, 0, 0, 0);
    pv_half<0>(o[0], vb, pa0, pa1, pa2, pa3); pv_half<1>(o[1], vb, pa0, pa1, pa2, pa3);
}
typedef short v4i16_t __attribute__((ext_vector_type(4)));
__device__ __forceinline__ s16x4 vtr(const LAS char* p) { return __builtin_bit_cast(s16x4, __builtin_amdgcn_ds_read_tr16_b64_v4i16((LAS v4i16_t*)p)); }
template <bool EXACT> __device__ __forceinline__ bool attn_unit(int b, int h, int qb, const bf16_t* __restrict__ Q, const bf16_t* __restrict__ KN, const bf16_t* __restrict__ KRp, const bf16_t* __restrict__ VV,
                                          bf16_t* MIX, float* PARTA, char* lds, const LAS char* lds3, const int wid) {
    int tid = tid_of(wid); asm volatile("" : "+v"(tid));
    const int lane = tid & 63, r32 = lane & 31, hi = lane >> 5;
    char* V_lds = lds + OFF_V; char* K_lds = lds + OFF_K;
    float* ws = (float*)(lds + OFF_WS) + wid * 64; float* al_l = ws + 32;
    float mhat = 0.f; f32x16 o[2] = {}; f32x4 osum = {}; f32x16 negm = {}; if (EXACT) asm volatile("" : "+v"(negm)); const f32x16 zero16 = {}; bf16x8 qr[6];
    const int lrow0 = (lane >> 4) * 4 + ((lane >> 3) & 1) * 16;
    bf16x8 ones; { const unsigned o1 = (((lane >> 4) ^ (lane >> 3)) & 1) ? 0u : 0x3F803F80u; const u32x4 w1 = {o1, o1, o1, o1}; ones = *reinterpret_cast<const bf16x8*>(&w1); asm volatile("" : "+v"(ones)); }
    const int xr0 = b * SEQ + qb * 256 + wid * QBLK;
    const bf16_t* Qw = Q + (size_t)(xr0 + r32) * 768 + h * 96 + hi * 8;
#pragma unroll
    for (int d0 = 0; d0 < 6; ++d0) qr[d0] = *reinterpret_cast<const bf16x8*>(Qw + d0 * 16);
    const size_t kvb = (size_t)b * KVR;
    const bf16_t* kn_src = KN + (kvb + (lane ^ wid)) * 512 + h * 64 + wid * 8;
    const int vkk = 8 * wid + ((lane & 31) >> 2), vkey = (vkk & ~0xC) | ((vkk & 4) << 1) | ((vkk & 8) >> 1);
    const bf16_t* vv_src = VV + (kvb + vkey) * 512 + h * 64 + (lane >> 5) * 32 + (lane & 3) * 8;
    const bf16_t* kr_src = KRp + (kvb + (lane ^ (wid & 3))) * 32 + (wid & 3) * 8;
    const int krow = (r32 & ~0xC) | ((r32 & 4) << 1) | ((r32 & 8) >> 1);
    const int kbase = hi * 1024 + ((krow ^ hi) << 4);
    int kx[4];
#pragma unroll
    for (int i = 0; i < 4; ++i) kx[i] = kbase ^ (i << 5);
    const int vb0 = (int)(uintptr_t)V_lds + v_rd_base(lane);
    const LAS char* vp0 = lds3 + OFF_V + v_rd_base(lane);
    const LAS char* kp0 = lds3 + OFF_K;
    const bool do_rope = wid < 4;
#define DMA16(gp, lp) __builtin_amdgcn_global_load_lds((const unsigned*)(gp), (LAS unsigned*)(lp), 16, 0, 0)
#define SDMA_K(slot, t) DMA16(kn_src + (size_t)(t) * KVBLK * 512, lds3 + OFF_K + (slot) * SHM_K + wid * 1024)
#define SDMA_V(slot, t) DMA16(vv_src + (size_t)(t) * KVBLK * 512, lds3 + OFF_V + (slot) * SHM_V + wid * 1024)
#define SDMA_R(slot, t) do { if (do_rope) DMA16(kr_src + (size_t)(t) * KVBLK * 32, lds3 + OFF_K + (slot) * SHM_K + (8 + wid) * 1024); } while (0)
#define SDMA(slot, t) do { SDMA_K(slot, t); SDMA_V(slot, t); SDMA_R(slot, t); } while (0)
#define DMA_SYNC() do { asm volatile("s_waitcnt vmcnt(0)" ::: "memory"); __syncthreads(); } while (0)
#define RESC(a) do { if (__any((a) < 1.f)) { if (hi == 0) al_l[r32] = (a); asm volatile("s_waitcnt lgkmcnt(0)" ::: "memory"); \
    _Pragma("unroll") for (int r = 0; r < 16; ++r) { const float f_ = al_l[crow(r, hi)]; o[0][r] *= f_; o[1][r] *= f_; } \
    _Pragma("unroll") for (int r = 0; r < 4; ++r) osum[r] *= al_l[lrow0 + r]; } } while (0)
    f32x16 pA0, pA1, pB0, pB1; float alA, alB; bf16x8 pa0, pa1, pa2, pa3;
    int s_prev = 0, s_cur = 0, s_next = 1;
#define ROT() do { s_prev = s_cur; s_cur = s_next; s_next = (s_next == 2) ? 0 : s_next + 1; } while (0)
    SDMA(0, 0); SDMA(1, 1);
    DMA_SYNC();
    qkt(pA0, pA1, K_lds, kx, qr, negm); if (EXACT) rowcheck<true>(pA0, pA1, mhat, negm, alA);
    exp16(pA0); if (!EXACT) exp16(pA1);
    ROT();
#define MF(A_, B_, C_) __builtin_amdgcn_mfma_f32_32x32x16_bf16(A_, B_, C_, 0, 0, 0)
#define MFS(A_, B_, C_) __builtin_amdgcn_mfma_f32_16x16x32_bf16(A_, B_, C_, 0, 0, 0)
#define EX2(P, i) do { P[i] = __builtin_amdgcn_exp2f(P[i]); P[(i) + 1] = __builtin_amdgcn_exp2f(P[(i) + 1]); asm volatile("" : "+v"(P)); } while (0)
#define KF(d0, half) (*(const LAS bf16x8*)(kp_ + (d0) * 2048 + kx[(d0) & 3] + (half) * 512))
#define VR(d0, ks, half) vtr(vp_ + v_rd_off(d0, ks, half))
#define MX3(a, b, c) __builtin_fmaxf(__builtin_fmaxf((a), (b)), (c))
#define EX1(P, i) do { P[i] = __builtin_amdgcn_exp2f(P[i]); asm volatile("" : "+v"(P)); } while (0)
#define PERMW(OUT) do { u32x4 w_ = {ua0, ua1, ub0, ub1}; OUT = *reinterpret_cast<bf16x8*>(&w_); } while (0)
#define STEP(C0, C1, ALC, P0, P1, t, MASKED) do { \
    const LAS char* kp_ = kp0 + s_cur * SHM_K; const LAS char* vp_ = vp0 + s_prev * SHM_V; \
    unsigned ua0, ua1, ub0, ub1; \
    bf16x8 ka0 = KF(0, 0), kb0 = KF(0, 1), ka1 = KF(1, 0), kb1 = KF(1, 1); \
    SBAR(); \
    if ((t) + 1 < NT) SDMA(s_next, (t) + 1);        \
    SBAR(); \
    C0 = MF(ka0, qr[0], (EXACT ? negm : zero16)); if (EXACT) EX2(P1, 0); ua0 = cvt_pk_bf16(P0[0], P0[1]); ua1 = cvt_pk_bf16(P0[2], P0[3]); SBAR(); \
    C1 = MF(kb0, qr[0], (EXACT ? negm : zero16)); if (EXACT) EX2(P1, 2); ub0 = cvt_pk_bf16(P0[4], P0[5]); ub1 = cvt_pk_bf16(P0[6], P0[7]); ka0 = KF(2, 0); kb0 = KF(2, 1); SBAR(); \
    C0 = MF(ka1, qr[1], C0); if (EXACT) EX2(P1, 4); PERMW(pa0); SBAR(); \
    C1 = MF(kb1, qr[1], C1); if (EXACT) EX2(P1, 6); ua0 = cvt_pk_bf16(P0[8], P0[9]); ua1 = cvt_pk_bf16(P0[10], P0[11]); SBAR(); \
    C0 = MF(ka0, qr[2], C0); if (EXACT) EX2(P1, 8); ub0 = cvt_pk_bf16(P0[12], P0[13]); ub1 = cvt_pk_bf16(P0[14], P0[15]); ka1 = KF(3, 0); kb1 = KF(3, 1); SBAR(); \
    C1 = MF(kb0, qr[2], C1); if (EXACT) EX2(P1, 10); PERMW(pa1); SBAR(); \
    C0 = MF(ka1, qr[3], C0); if (EXACT) EX2(P1, 12); ua0 = cvt_pk_bf16(P1[0], P1[1]); ua1 = cvt_pk_bf16(P1[2], P1[3]); ka0 = KF(4, 0); kb0 = KF(4, 1); SBAR(); \
    C1 = MF(kb1, qr[3], C1); if (EXACT) EX2(P1, 14); ub0 = cvt_pk_bf16(P1[4], P1[5]); ub1 = cvt_pk_bf16(P1[6], P1[7]); SBAR(); \
    C0 = MF(ka0, qr[4], C0); PERMW(pa2); ua0 = cvt_pk_bf16(P1[8], P1[9]); ka1 = KF(5, 0); kb1 = KF(5, 1); SBAR(); \
    C1 = MF(kb0, qr[4], C1); ua1 = cvt_pk_bf16(P1[10], P1[11]); ub0 = cvt_pk_bf16(P1[12], P1[13]); SBAR(); \
    C0 = MF(ka1, qr[5], C0); ub1 = cvt_pk_bf16(P1[14], P1[15]); SBAR(); \
    C1 = MF(kb1, qr[5], C1); PERMW(pa3); SBAR(); \
    if (MASKED) { _Pragma("unroll") for (int r = 8; r < 16; ++r) C0[r] = -INFINITY; _Pragma("unroll") for (int r = 0; r < 16; ++r) C1[r] = -INFINITY; } \
    s16x4 v00 = VR(0, 0, 0), v01 = VR(0, 0, 1), v10 = VR(1, 0, 0), v11 = VR(1, 0, 1); float ma_ = 0.f, mb_ = 0.f; (void)ma_; (void)mb_; \
    SBAR(); \
    osum = MFS(pa0, ones, osum); if (!EXACT) { EX2(C0, 0); EX1(C0, 2); } if (EXACT) { ma_ = MX3(C0[0], C0[1], C1[0]); mb_ = MX3(C0[2], C0[3], C1[1]); ma_ = MX3(ma_, C1[2], C1[3]); mb_ = MX3(mb_, C0[4], C0[5]); } SBAR(); \
    osum = MFS(pa1, ones, osum); if (!EXACT) { EX1(C0, 3); EX2(C0, 4); } if (EXACT) { ma_ = MX3(ma_, C0[6], C0[7]); mb_ = MX3(mb_, C1[4], C1[5]); ma_ = MX3(ma_, C1[6], C1[7]); mb_ = MX3(mb_, C0[8], C0[9]); } SBAR(); \
    osum = MFS(pa2, ones, osum); if (!EXACT) { EX2(C0, 6); } if (EXACT) { ma_ = MX3(ma_, C0[10], C0[11]); mb_ = MX3(mb_, C1[8], C1[9]); ma_ = MX3(ma_, C1[10], C1[11]); mb_ = MX3(mb_, C0[12], C0[13]); } SBAR(); \
    osum = MFS(pa3, ones, osum); ALC = 1.f; if (!EXACT) { EX2(C0, 8); EX1(C0, 10); } \
    if (EXACT) { ma_ = MX3(ma_, C0[14], C0[15]); mb_ = MX3(mb_, C1[12], C1[13]); ma_ = MX3(ma_, C1[14], C1[15]); \
      float rm_ = __builtin_fmaxf(ma_, mb_); auto rr_ = __builtin_amdgcn_permlane32_swap(__float_as_uint(rm_), __float_as_uint(rm_), false, false); rm_ = __builtin_fmaxf(__uint_as_float(rr_[0]), __uint_as_float(rr_[1])); \
      if (__builtin_expect(__any(rm_ > THR), 0)) { const float dl_ = __builtin_fmaxf(rm_, 0.f); mhat += dl_; \
        _Pragma("unroll") for (int r = 0; r < 16; ++r) { C0[r] -= dl_; C1[r] -= dl_; } \
        _Pragma("unroll") for (int r = 0; r < 16; ++r) negm[r] = -mhat; asm volatile("" : "+v"(negm)); \
        ALC = __builtin_amdgcn_exp2f(-dl_); } } \
    SBAR(); \
    o[0] = MF(pa0, PKV(v00, v01), o[0]); if (EXACT) EX2(C0, 0); else { EX1(C0, 11); EX2(C0, 12); } s16x4 w00 = VR(0, 1, 0), w01 = VR(0, 1, 1), w10 = VR(1, 1, 0), w11 = VR(1, 1, 1); SBAR(); \
    o[1] = MF(pa0, PKV(v10, v11), o[1]); if (EXACT) EX2(C0, 2); else { EX2(C0, 14); } SBAR(); \
    o[0] = MF(pa1, PKV(w00, w01), o[0]); if (EXACT) EX2(C0, 4); else { EX2(C1, 0); EX1(C1, 2); } v00 = VR(0, 2, 0); v01 = VR(0, 2, 1); v10 = VR(1, 2, 0); v11 = VR(1, 2, 1); SBAR(); \
    o[1] = MF(pa1, PKV(w10, w11), o[1]); if (EXACT) EX2(C0, 6); else { EX1(C1, 3); EX2(C1, 4); } SBAR(); \
    o[0] = MF(pa2, PKV(v00, v01), o[0]); if (EXACT) EX2(C0, 8); else { EX2(C1, 6); } w00 = VR(0, 3, 0); w01 = VR(0, 3, 1); w10 = VR(1, 3, 0); w11 = VR(1, 3, 1); SBAR(); \
    o[1] = MF(pa2, PKV(v10, v11), o[1]); if (EXACT) EX2(C0, 10); else { EX2(C1, 8); EX1(C1, 10); } SBAR(); \
    o[0] = MF(pa3, PKV(w00, w01), o[0]); if (EXACT) EX2(C0, 12); else { EX1(C1, 11); EX2(C1, 12); } SBAR(); \
    o[1] = MF(pa3, PKV(w10, w11), o[1]); if (EXACT) EX2(C0, 14); else { EX2(C1, 14); } SBAR(); \
    if (EXACT) RESC(ALC); \
    DMA_SYNC(); ROT(); } while (0)
    for (int j = 1; j < NT - 2; j += 2) {
        STEP(pB0, pB1, alB, pA0, pA1, j, false);
        STEP(pA0, pA1, alA, pB0, pB1, j + 1, false);
    }
    STEP(pB0, pB1, alB, pA0, pA1, NT - 2, false);
    STEP(pA0, pA1, alA, pB0, pB1, NT - 1, true);
    if (EXACT) exp16(pA1);
    packP(pA0, pA1, pa0, pa1, pa2, pa3); SBAR();
    pv_all(o, osum, ones, vb0 + s_prev * SHM_V, pa0, pa1, pa2, pa3);
    bool ok = true;
    if (!EXACT) {
        float lo = osum[0], hi_ = osum[0], om = 0.f;
#pragma unroll
        for (int r = 1; r < 4; ++r) { lo = __builtin_fminf(lo, osum[r]); hi_ = __builtin_fmaxf(hi_, osum[r]); }
#pragma unroll
        for (int r = 0; r < 16; ++r) om = __builtin_fmaxf(om, __builtin_fmaxf(__builtin_fabsf(o[0][r]), __builtin_fabsf(o[1][r])));
        bool good = (lo > 0.f) && (hi_ < 1e37f) && (om < 1e37f);
#pragma unroll
        for (int r = 0; r < 16; ++r) good = good && (osum[r & 3] == osum[r & 3]) && (o[0][r] == o[0][r]) && (o[1][r] == o[1][r]);
        LAS unsigned* okf = (LAS unsigned*)(lds3 + OFF_WS);
        if (lane == 0) okf[wid * 64] = __all(good) ? 1u : 0u;
        __syncthreads();
        unsigned all_ok = 1u;
#pragma unroll
        for (int w = 0; w < NW; ++w) all_ok &= okf[w * 64];
        ok = all_ok != 0u;
        __syncthreads();
        if (!ok) return false;
    }
    float rli[16];
    if ((lane & 7) == 0) {
#pragma unroll
        for (int r = 0; r < 4; ++r) ws[lrow0 + r] = osum[r]; }
    asm volatile("s_waitcnt lgkmcnt(0)" ::: "memory");
#pragma unroll
    for (int r = 0; r < 16; ++r) rli[r] = __builtin_amdgcn_rcpf(ws[crow(r, hi)]);
    float* stg = (float*)(lds + OFF_OST + wid * OST_WAVE);
#pragma unroll
    for (int r = 0; r < 16; ++r) { const int orow = crow(r, hi);
#pragma unroll
        for (int d0 = 0; d0 < 2; ++d0) stg[orow * 68 + d0 * 32 + r32] = o[d0][r] * rli[r]; }
    asm volatile("s_waitcnt lgkmcnt(0)" ::: "memory");
    { const int row = lane >> 1, half = lane & 1; const float* s = stg + row * 68 + half * 32; f32x4 v[8]; float ss = 0.f;
#pragma unroll
      for (int i = 0; i < 8; ++i) { v[i] = *(const f32x4*)(s + 4 * i); ss += (v[i][0] * v[i][0] + v[i][1] * v[i][1]) + (v[i][2] * v[i][2] + v[i][3] * v[i][3]); }
      ss += __shfl_xor(ss, 1);
      bf16_t* dst = MIX + (size_t)(xr0 + row) * 1024 + h * 64 + half * 32;
#pragma unroll
      for (int i = 0; i < 4; ++i) *(u32x4*)(dst + 8 * i) = pack8(v[2 * i], v[2 * i + 1]);
      if (half == 0) PARTA[(size_t)(xr0 + row) * 8 + h] = ss; }
    __syncthreads();
    return ok;
#undef SDMA
#undef SDMA_K
#undef SDMA_V
#undef SDMA_R
#undef DMA16
#undef DMA_SYNC
#undef RESC
#undef ROT
#undef STEP
#undef PKV
#undef MF
#undef MFS
#undef EX2
#undef KF
#undef VR
#undef MX3
#undef EX1
#undef PERMW
}
#undef SBAR
static_assert(LDS_END <= LDS_BYTES - 64, "attention LDS");
}

template <int MID> __device__ __forceinline__ int srccol(int n) {
    if (MID == 0) { if (n < 640) return n; if (n < 1152) return n + 32; if (n < 1184) { const int t = n - 1152; return 640 + ((t & 1) ? 16 + (t >> 1) : (t >> 1)); } return -1; }
    if (MID == 1) { const int h = n / 96, t = n % 96; if (t < 64) return n; const int tt = t - 64; return h * 96 + 64 + ((tt & 1) ? 16 + (tt >> 1) : (tt >> 1)); }
    if (MID == 2) { if (n < 512) return (n >> 6) * 128 + (n & 63); const int mm = n - 512; return (mm >> 6) * 128 + 64 + (mm & 63); }
    if (MID == 3) { const int tile = n >> 8, c = n & 255; return c < 128 ? 128 * tile + c : 512 + 128 * tile + (c - 128); }
    return n;
}
template <int MID> __device__ __forceinline__ void transpose_item(const float* W, int K, int N, int Nsrc, const float* kscale, bf16_t* WT, LAS float* scr, int item, int lane, int ldw = 0) {
    if (ldw == 0) ldw = K;
    const int nblk = N / 32, kb = item / nblk, nb = item % nblk, k0 = 64 * kb, n0 = 32 * nb;
    const int src = srccol<MID>(n0 + (lane & 31));
    float tv[32];
#pragma unroll
    for (int i = 0; i < 32; ++i) { const int kk = 2 * i + (lane >> 5); tv[i] = src >= 0 ? __builtin_nontemporal_load(W + (size_t)(k0 + kk) * Nsrc + src) : 0.f; }
#pragma unroll
    for (int i = 0; i < 32; ++i) { const int kk = 2 * i + (lane >> 5); float v = tv[i]; if (kscale) v *= kscale[k0 + kk]; scr[kk * 33 + (lane & 31)] = v; }
    LDS_WAIT(); asm volatile("" ::: "memory");
    const int c = lane & 7;
#pragma unroll
    for (int j = 0; j < 4; ++j) { const int n = (lane >> 3) + 8 * j; const LAS float* s = scr + (8 * c) * 33 + n;
        u32x4 o; o.x = cvt_pk_bf16(s[0 * 33], s[1 * 33]); o.y = cvt_pk_bf16(s[2 * 33], s[3 * 33]); o.z = cvt_pk_bf16(s[4 * 33], s[5 * 33]); o.w = cvt_pk_bf16(s[6 * 33], s[7 * 33]);
        *(u32x4*)(WT + (size_t)(n0 + n) * ldw + k0 + 8 * c) = o; }
    LDS_WAIT(); asm volatile("" ::: "memory");
}
__device__ __forceinline__ void lam_pow(float lr, float li, float dt, float k, float& re, float& im) {
    const float mag = __expf(lr * dt * k);
    double t = (double)li * (double)dt * (double)k * 0.15915494309189535; t -= __builtin_rint(t);
    const float f = (float)t;
    re = mag * __builtin_amdgcn_cosf(f); im = mag * __builtin_amdgcn_sinf(f);
}
struct SsmP { float lr, li, dt, qr, qi; };
__device__ __forceinline__ SsmP ssm_params(const float* A_re, const float* A_im, const float* log_dt, int dir, int g, int p) {
    SsmP s; s.lr = fminf(A_re[(dir * 32 + g) * 64 + p], -1e-4f); s.li = A_im[(dir * 32 + g) * 64 + p]; s.dt = __expf(log_dt[dir * 32 + g]);
    float br, bi; lam_pow(s.lr, s.li, s.dt, 1.f, br, bi);
    const float nr = br - 1.f, ni = bi, den = 1.0f / (s.lr * s.lr + s.li * s.li);
    s.qr = (nr * s.lr + ni * s.li) * den; s.qi = (ni * s.lr - nr * s.li) * den; return s;
}


#define XB_TMO      128
#define XB_XCNT(j)  (256  + 64 * (j))
#define XB_XSUB(j)  (1280 + 64 * (j))
#define XB_XGEN(j)  (2304 + 64 * (j))
#define XB_TOP      3328
#define XB_TOPGEN   3392
#define XCD_BAR_WORDS 3456
#define XB_SPIN_CAP (1u << 22)
constexpr size_t WS_BAR = 65536;
__device__ __forceinline__ unsigned xb_ld(unsigned* p)              { return __hip_atomic_load(p, __ATOMIC_RELAXED, __HIP_MEMORY_SCOPE_AGENT); }
__device__ __forceinline__ unsigned xb_add(unsigned* p, unsigned v) { return __hip_atomic_fetch_add(p, v, __ATOMIC_RELAXED, __HIP_MEMORY_SCOPE_AGENT); }
__device__ __forceinline__ unsigned xb_xcc_id() { return (unsigned)__builtin_amdgcn_s_getreg((3 << 11) | 20) & 0xFu; }
#define XB_SPIN(cond, bar) do { unsigned _sp = 0; while (cond) { __builtin_amdgcn_s_sleep(1); \
    if ((++_sp & 255u) == 0u) { if (xb_ld(&(bar)[XB_TMO])) break; if (_sp > XB_SPIN_CAP) { atomicAdd(&(bar)[XB_TMO], 1u); break; } } } } while (0)
struct XcdBarrier { unsigned* bar; unsigned x; volatile LAS unsigned* st; };
__device__ __forceinline__ XcdBarrier xcd_barrier_post(unsigned* bar, volatile LAS unsigned* st) {
    XcdBarrier b; b.bar = bar; b.x = xb_xcc_id(); b.st = st;
    if (threadIdx.x == 0) (void)xb_add(&bar[XB_XCNT(b.x)], 1u);
    return b;
}
__device__ __forceinline__ void xcd_barrier_complete(unsigned* bar, unsigned x, unsigned& nloc, unsigned& nx) {
    const unsigned G = gridDim.x * gridDim.y * gridDim.z;
    unsigned sum, cnt, mine, sp = 0u;
    for (;;) {
        sum = 0u; cnt = 0u; mine = 0u;
#pragma unroll
        for (unsigned j = 0; j < 16; ++j) { const unsigned c = xb_ld(&bar[XB_XCNT(j)]); sum += c; cnt += (c > 0u) ? 1u : 0u; mine = (j == x) ? c : mine; }
        if (sum == G) break;
        __builtin_amdgcn_s_sleep(1);
        if ((++sp & 255u) == 0u) { if (xb_ld(&bar[XB_TMO])) break; if (sp > XB_SPIN_CAP) { atomicAdd(&bar[XB_TMO], 1u); break; } }
    }
    nloc = mine > 0u ? mine : 1u; nx = cnt > 0u ? cnt : 1u;
}
__device__ __forceinline__ void xcd_barrier(const XcdBarrier& b) {
    asm volatile("s_waitcnt vmcnt(0)" ::: "memory");
    __syncthreads();
    if (threadIdx.x == 0) {
        unsigned* bar = b.bar;
        __builtin_amdgcn_s_waitcnt(0);
        unsigned nloc = b.st[0], nx = b.st[1];
        if (nloc == 0u) { xcd_barrier_complete(bar, b.x, nloc, nx); b.st[0] = nloc; b.st[1] = nx; }
        const unsigned old = xb_add(&bar[XB_XSUB(b.x)], 1u);
        const unsigned gen = old / nloc;
        if (old + 1u == (gen + 1u) * nloc) {
            __builtin_amdgcn_fence(__ATOMIC_RELEASE, "agent");
            asm volatile("s_waitcnt vmcnt(0)" ::: "memory");
            const unsigned og = xb_add(&bar[XB_TOP], 1u);
            const unsigned tg = og / nx;
            if (og + 1u == (tg + 1u) * nx) xb_add(&bar[XB_TOPGEN], 1u);
            else XB_SPIN(xb_ld(&bar[XB_TOPGEN]) == tg, bar);
            xb_add(&bar[XB_XGEN(b.x)], 1u);
            __builtin_amdgcn_fence(__ATOMIC_ACQUIRE, "agent");
            asm volatile("s_waitcnt vmcnt(0)" ::: "memory");
        } else {
            XB_SPIN(xb_ld(&bar[XB_XGEN(b.x)]) == gen, bar);
            __builtin_amdgcn_fence(__ATOMIC_ACQUIRE, "agent");
            asm volatile("s_waitcnt vmcnt(0)" ::: "memory");
        }
    }
    __syncthreads();
}

#define XL_FLAG     3520
#define XL_P6DONE   3552
#define XL_ID       3584
#define XL_CNT(g, k) (4096 + 64 * ((g) * 4 + (k)))
__device__ __forceinline__ void xl_barrier(unsigned* bar, unsigned* cnt, unsigned members) {
    asm volatile("s_waitcnt vmcnt(0)" ::: "memory");
    __syncthreads();
    if (threadIdx.x == 0) {
        (void)xb_add(cnt, 1u);
        XB_SPIN(xb_ld(cnt) < members, bar);
        __builtin_amdgcn_fence(__ATOMIC_ACQUIRE, "agent");
        asm volatile("s_waitcnt vmcnt(0)" ::: "memory");
    }
    __syncthreads();
}

struct Args {
    const float *x, *meta, *g_pre_mix, *w_in, *g_q_lat, *w_uq, *g_kv_lat, *w_ukv, *A_re, *A_im, *log_dt, *B_re, *B_im, *C_re, *C_im, *Dv, *w_glu, *g_mix_out, *w_out, *g_post_mix, *g_pre_mlp, *w_up, *w_down, *g_post_mlp;
    const int* positions; float* out; unsigned char* ws;
};

__global__ void __launch_bounds__(NTHR, 2) fwd_megakernel(Args a) {
    extern __shared__ __attribute__((aligned(16))) unsigned char lds_raw[];
    cg::grid_group grid = cg::this_grid();
    LAS unsigned char* lds = (LAS unsigned char*)lds_raw;
    const int wave = __builtin_amdgcn_readfirstlane(threadIdx.x >> 6);
    const int G = gridDim.x, bid = blockIdx.x;
    const int gw = bid * NWAVES + wave, NGW = G * NWAVES, NGT = G * NTHR;
#define TID_FRESH() const int tid = tid_of(wave), lane = tid & 63, gt = bid * NTHR + tid; (void)lane; (void)gt
    typedef const __attribute__((address_space(4))) Args* ArgP;
    const ArgP ap0 = (ArgP)__builtin_amdgcn_kernarg_segment_ptr();
#define ARGS_FRESH() ArgP ap = ap0; asm volatile("" : "+s"(ap))
    unsigned char* ws = ap0->ws;
#define STAMP(k) do { if (PROBE_A >= 0 && blockIdx.x == 0 && tid_of(wave) == 0) ((unsigned long long*)ws)[k] = __builtin_amdgcn_s_memrealtime(); } while (0)
    STAMP(0);
    { volatile LAS unsigned* st0 = (volatile LAS unsigned*)(lds + XBST_OFF); if (threadIdx.x == 0) { st0[0] = 0u; st0[1] = 0u; } __syncthreads(); }
    (void)xcd_barrier_post((unsigned*)(ws + WS_BAR), (volatile LAS unsigned*)(lds + XBST_OFF));
    const unsigned my_xcc = xb_xcc_id() + 1u;
    if (threadIdx.x == 0) __hip_atomic_store((unsigned*)(ws + WS_BAR) + XL_ID + bid, my_xcc, RLX_AGENT);
#define XBAR() do { XcdBarrier xb_; xb_.bar = (unsigned*)(ws + WS_BAR); xb_.x = xb_xcc_id(); xb_.st = (volatile LAS unsigned*)(lds + XBST_OFF); xcd_barrier(xb_); } while (0)
#define P_Win ((bf16_t*)(ws + WS_WIN))
#define P_Wuq ((bf16_t*)(ws + WS_WUQ))
#define P_Wukv ((bf16_t*)(ws + WS_WUKV))
#define P_Wglu ((bf16_t*)(ws + WS_WGLU))
#define P_Wout ((bf16_t*)(ws + WS_WOUT))
#define P_Wup ((bf16_t*)(ws + WS_WUP))
#define P_Wdn ((bf16_t*)(ws + WS_WDN))
#define P_Bst ((bf16_t*)(ws + WS_BST))
#define P_Mout ((bf16_t*)(ws + WS_MOUT))
#define P_KTAB ((float*)(ws + WS_KTAB))
#define P_TAB ((float*)(ws + WS_TAB))
#define P_PART ((float*)(ws + WS_PART))
#define P_PARTA ((float*)(ws + WS_PARTA))
#define P_PARTS ((float*)(ws + WS_PARTS))
#define P_UM ((float*)(ws + WS_UM))
#define P_XN ((bf16_t*)(ws + WS_XN))
#define P_XRS ((float*)(ws + 256 * 1024))
#define P_CQ ((bf16_t*)(ws + WS_CQ))
#define P_UP ((bf16_t*)(ws + WS_UP))
#define P_Q ((bf16_t*)(ws + WS_Q))
#define P_KN ((bf16_t*)(ws + WS_KN))
#define P_VV ((bf16_t*)(ws + WS_VV))
#define P_KR ((bf16_t*)(ws + WS_KR))
#define P_Sst ((float*)(ws + WS_S))
#define P_MIX ((bf16_t*)(ws + WS_MIX))
#define P_Y ((bf16_t*)(ws + WS_Y))
#define P_XN2 ((bf16_t*)(ws + WS_XN2))
#define P_H ((bf16_t*)(ws + WS_H))
#define P_V1 ((float*)(ws + WS_V1))
#define P_M2 ((float*)(ws + WS_M2))

    {
        ARGS_FRESH(); TID_FRESH();
        LAS float* scr = (LAS float*)(lds + wave * 16384);
        constexpr int I0 = 16 * 40, I1 = 6 * 24, I2 = 4 * 32, I3 = 8 * 32, I4 = 16 * 32, I5 = 16 * 128, I6 = 64 * 32;
        constexpr int NITEMS = I0 + I1 + I2 + I3 + I4 + I5 + I6;
        for (int it = gw; it < NITEMS; it += NGW) {
            int r = it;
            if (r < I0) { transpose_item<0>(ap->w_in, 1024, 1280, 1184, ap->g_pre_mix, P_Win, scr, r, lane); continue; } r -= I0;
            if (r < I1) { transpose_item<1>(ap->w_uq, 384, 768, 768, ap->g_q_lat, P_Wuq, scr, r, lane, 512); continue; } r -= I1;
            if (r < I2) { transpose_item<2>(ap->w_ukv, 256, 1024, 1024, ap->g_kv_lat, P_Wukv, scr, r, lane, 512); continue; } r -= I2;
            if (r < I3) { transpose_item<3>(ap->w_glu, 512, 1024, 1024, nullptr, P_Wglu, scr, r, lane); continue; } r -= I3;
            if (r < I4) { transpose_item<4>(ap->w_out, 1024, 1024, 1024, ap->g_mix_out, P_Wout, scr, r, lane); continue; } r -= I4;
            if (r < I5) { transpose_item<5>(ap->w_up, 1024, 4096, 4096, ap->g_pre_mlp, P_Wup, scr, r, lane); continue; } r -= I5;
            transpose_item<6>(ap->w_down, 4096, 1024, 1024, nullptr, P_Wdn, scr, r, lane);
        }
        for (int m0 = gw * 4; m0 < MX + NMETA; m0 += NGW * 4) {
            f32x4 v[4][4]; float ss[4];
#pragma unroll
            for (int r = 0; r < 4; ++r) { const int m = m0 + r; const float* xr = m < MX ? ap->x + (size_t)m * DM : ap->meta + (size_t)(m - MX) * DM;
#pragma unroll
                for (int j = 0; j < 2; ++j) { v[r][2 * j] = __builtin_nontemporal_load((const f32x4*)(xr + 8 * lane + 512 * j)); v[r][2 * j + 1] = __builtin_nontemporal_load((const f32x4*)(xr + 8 * lane + 512 * j + 4)); } }
#pragma unroll
            for (int r = 0; r < 4; ++r) { float s_ = 0.f;
#pragma unroll
                for (int j = 0; j < 4; ++j) s_ += (v[r][j][0] * v[r][j][0] + v[r][j][1] * v[r][j][1]) + (v[r][j][2] * v[r][j][2] + v[r][j][3] * v[r][j][3]);
                ss[r] = s_; }
#pragma unroll
            for (int o_ = 1; o_ < 64; o_ <<= 1) {
#pragma unroll
                for (int r = 0; r < 4; ++r) ss[r] += __shfl_xor(ss[r], o_); }
#pragma unroll
            for (int j = 0; j < 2; ++j) {
#pragma unroll
                for (int r = 0; r < 4; ++r) *(u32x4*)(P_XN + (size_t)(m0 + r) * DM + 8 * lane + 512 * j) = pack8(v[r][2 * j], v[r][2 * j + 1]); }
            if (lane < 4) { float s_ = ss[0]; s_ = lane == 1 ? ss[1] : s_; s_ = lane == 2 ? ss[2] : s_; s_ = lane == 3 ? ss[3] : s_; P_XRS[m0 + lane] = __builtin_amdgcn_rsqf(s_ * (1.f / DM) + EPS); }
        }
        for (int id = gt; id < (MX + NMETA) * 16; id += NGT) {
            const int row = id >> 4, p = id & 15;
            const int pos = row < MX ? ap->positions[row] + NMETA : row - MX;
            const float invq[4] = {1.0f, 0.5623413251903491f, 0.31622776601683794f, 0.1778279410038923f};
            const float dec[4] = {1.0f, 0.1f, 0.01f, 0.001f};
            const float inv = invq[p & 3] * dec[p >> 2];
            const float ang = (float)pos * inv;
            double t = (double)ang * 0.15915494309189535; t -= __builtin_rint(t); const float f = (float)t;
            P_TAB[(size_t)row * 32 + p] = __builtin_amdgcn_cosf(f); P_TAB[(size_t)row * 32 + 16 + p] = __builtin_amdgcn_sinf(f);
        }
        for (int un = gw; un < 32 * 2 * 32; un += NGW) {
            const int d = un & 31, dir = (un >> 5) & 1, g = un >> 6, p = lane;
            const SsmP sp = ssm_params(ap->A_re, ap->A_im, ap->log_dt, dir, g, p);
            float wr_, wi_; lam_pow(sp.lr, sp.li, sp.dt, (float)d, wr_, wi_);
            const float wqr = wr_ * sp.qr - wi_ * sp.qi, wqi = wr_ * sp.qi + wi_ * sp.qr;
            const float* Br = ap->B_re + ((size_t)(dir * 32 + g) * 64 + p) * 16; const float* Bi = ap->B_im + ((size_t)(dir * 32 + g) * 64 + p) * 16;
#pragma unroll
            for (int hh = 0; hh < 16; ++hh) { const float br = Br[hh], bi = Bi[hh]; scr[(p * 16 + hh) * 2] = wqr * br - wqi * bi; scr[(p * 16 + hh) * 2 + 1] = wqr * bi + wqi * br; }
            LDS_WAIT(); asm volatile("" ::: "memory");
            const int h = lane >> 2, hp0 = (lane & 3) * 4;
            const float* Cr = ap->C_re + ((size_t)(dir * 32 + g) * 16 + h) * 64; const float* Ci = ap->C_im + ((size_t)(dir * 32 + g) * 16 + h) * 64;
            f32x4 accv = {0.f, 0.f, 0.f, 0.f};
            f32x4 crv[16], civ[16];
#pragma unroll
            for (int q4 = 0; q4 < 16; ++q4) { crv[q4] = *(const f32x4*)(Cr + 4 * q4); civ[q4] = *(const f32x4*)(Ci + 4 * q4); }
#pragma unroll
            for (int pp = 0; pp < 64; ++pp) { const float cr = crv[pp >> 2][pp & 3], ci = civ[pp >> 2][pp & 3];
#pragma unroll
                for (int e = 0; e < 4; ++e) accv[e] += cr * scr[(pp * 16 + hp0 + e) * 2] - ci * scr[(pp * 16 + hp0 + e) * 2 + 1]; }
            *(f32x4*)(P_KTAB + ((size_t)((g * 2 + dir) * 32 + d)) * 256 + lane * 4) = accv;
            LDS_WAIT(); asm volatile("" ::: "memory");
        }
        for (int id = gt; id < 32 * 2 * 32 * 64; id += NGT) {
            const int p = id & 63, j = (id >> 6) & 31, dir = (id >> 11) & 1, g = id >> 12;
            const SsmP sp = ssm_params(ap->A_re, ap->A_im, ap->log_dt, dir, g, p);
            {
                float wr_, wi_; lam_pow(sp.lr, sp.li, sp.dt, dir == 0 ? (float)(31 - j) : (float)j, wr_, wi_);
                const float wqr = wr_ * sp.qr - wi_ * sp.qi, wqi = wr_ * sp.qi + wi_ * sp.qr;
                const float* Br = ap->B_re + ((size_t)(dir * 32 + g) * 64 + p) * 16; const float* Bi = ap->B_im + ((size_t)(dir * 32 + g) * 64 + p) * 16;
                float er[16], ei[16];
#pragma unroll
                for (int hh = 0; hh < 16; ++hh) { const float br = Br[hh], bi = Bi[hh]; er[hh] = wqr * br - wqi * bi; ei[hh] = wqr * bi + wqi * br; }
                bf16_t* dre = P_Bst + ((size_t)(g * 256 + dir * 128 + p)) * 512 + j * 16; bf16_t* dim_ = dre + (size_t)64 * 512;
                u32x4 w;
                w.x = cvt_pk_bf16(er[0], er[1]); w.y = cvt_pk_bf16(er[2], er[3]); w.z = cvt_pk_bf16(er[4], er[5]); w.w = cvt_pk_bf16(er[6], er[7]); *(u32x4*)dre = w;
                w.x = cvt_pk_bf16(er[8], er[9]); w.y = cvt_pk_bf16(er[10], er[11]); w.z = cvt_pk_bf16(er[12], er[13]); w.w = cvt_pk_bf16(er[14], er[15]); *(u32x4*)(dre + 8) = w;
                w.x = cvt_pk_bf16(ei[0], ei[1]); w.y = cvt_pk_bf16(ei[2], ei[3]); w.z = cvt_pk_bf16(ei[4], ei[5]); w.w = cvt_pk_bf16(ei[6], ei[7]); *(u32x4*)dim_ = w;
                w.x = cvt_pk_bf16(ei[8], ei[9]); w.y = cvt_pk_bf16(ei[10], ei[11]); w.z = cvt_pk_bf16(ei[12], ei[13]); w.w = cvt_pk_bf16(ei[14], ei[15]); *(u32x4*)(dim_ + 8) = w;
            }
            {
                const int i = j; float wr_, wi_; lam_pow(sp.lr, sp.li, sp.dt, dir == 0 ? (float)(i + 1) : (float)(32 - i), wr_, wi_);
                const float* Cr = ap->C_re + ((size_t)(dir * 32 + g) * 16) * 64 + p; const float* Ci = ap->C_im + ((size_t)(dir * 32 + g) * 16) * 64 + p;
                bf16_t* d0 = P_Mout + ((size_t)(g * 512 + i * 16)) * 768 + 512 + dir * 128 + p;
#pragma unroll
                for (int hh = 0; hh < 16; ++hh) { const float cr = Cr[hh * 64], ci = Ci[hh * 64]; const float zr = cr * wr_ - ci * wi_, zi = cr * wi_ + ci * wr_;
                    d0[(size_t)hh * 768] = f2bf(zr); d0[(size_t)hh * 768 + 64] = f2bf(-zi); }
            }
        }
        for (int id = gt; id < NB * 48 * 64; id += NGT) { const int c = id & 63, r = (id >> 6) % 48, b = id / (48 * 64); const size_t row = (size_t)b * KVR + SEQ + NMETA + r;
            const u32x4 z = {0u, 0u, 0u, 0u}; *(u32x4*)(P_KN + row * 512 + c * 8) = z; *(u32x4*)(P_VV + row * 512 + c * 8) = z; if (c < 4) *(u32x4*)(P_KR + row * 32 + c * 8) = z; }
    }
    if (__builtin_expect(ws == nullptr, 0)) grid.sync();
    XBAR();
    STAMP(1);
    if (wave == 0) {
        const int l_ = tid_of(wave) & 63; unsigned* bw_ = (unsigned*)(ws + WS_BAR);
        const unsigned v_ = (G == 256 && l_ < 32) ? xb_ld(bw_ + XL_ID + (bid & 7) + 8 * l_) : my_xcc;
        if (!__all(v_ == my_xcc) && l_ == 0) __hip_atomic_store(bw_ + XL_FLAG, 1u, RLX_AGENT);
    }

    {
        ARGS_FRESH(); TID_FRESH();
        for (int id0 = gt; id0 < 32 * 32 * 16 * 32 * 2; id0 += 8 * NGT) {
            f32x4 a0[8], a1[8], c0[8], c1[8]; float dd[8];
#pragma unroll
            for (int q = 0; q < 8; ++q) { const int id = id0 + q * NGT; a0[q] = (f32x4){0.f, 0.f, 0.f, 0.f}; a1[q] = a0[q]; c0[q] = a0[q]; c1[q] = a0[q]; dd[q] = 0.f;
                if (id < 32 * 32 * 16 * 32 * 2) {
                    const int h8 = id & 1, j = (id >> 1) & 31, h = (id >> 6) & 15, i = (id >> 10) & 31, g = id >> 15;
                    const float* kf = P_KTAB + ((size_t)((g * 2 + 0) * 32)) * 256 + h * 16 + h8 * 8; const float* kb = P_KTAB + ((size_t)((g * 2 + 1) * 32)) * 256 + h * 16 + h8 * 8;
                    const float* s = (j < i) ? kf + (size_t)(i - j) * 256 : kb + (size_t)(j - i) * 256;
                    a0[q] = *(const f32x4*)s; a1[q] = *(const f32x4*)(s + 4);
                    if (j == i) { c0[q] = *(const f32x4*)kf; c1[q] = *(const f32x4*)(kf + 4); dd[q] = ap->Dv[g * 16 + h]; } } }
#pragma unroll
            for (int q = 0; q < 8; ++q) { const int id = id0 + q * NGT;
                if (id < 32 * 32 * 16 * 32 * 2) {
                    const int h8 = id & 1, j = (id >> 1) & 31, h = (id >> 6) & 15, i = (id >> 10) & 31, g = id >> 15;
                    f32x4 v0 = a0[q] + c0[q], v1 = a1[q] + c1[q];
                    if (j == i) { const int e = h - h8 * 8; if (e >= 0 && e < 4) v0[e] += dd[q]; else if (e >= 4 && e < 8) v1[e - 4] += dd[q]; }
                    *(u32x4*)(P_Mout + ((size_t)(g * 512 + i * 16 + h)) * 768 + j * 16 + h8 * 8) = pack8(v0, v1); } }
        }
        pg8::Gemm g{P_XN, P_Win, 1024, 1024, 1024, 0, 0}; pg8::Order S; S.init(MT / 256, 5, 1, G, bid);
        LAS float* rtab = (LAS float*)(lds + TAB_OFF);
        { Unit u; const int r_ = tid & 255; for (int ui = tid >> 8; S.next(ui, u); ui += 2) { const int row = u.pm * 256 + r_; rtab[ui * 256 + r_] = row < MX + NMETA ? P_XRS[row] : 0.f; } }
        __syncthreads();
        EpiProj E{P_CQ, P_UP, P_KR, P_PART, P_UM, P_TAB, rtab};
        pg8::gemm_phase<EpiProj, true>(lds, g, S, E, wave);
    }
    XBAR();
    STAMP(2);

    {
        TID_FRESH();
        struct Order2 { pg8::Order oq, okv, ost; int G, c;
            __device__ __forceinline__ bool next(int i, Unit& u) const { const long L = (long)i * G + c;
                if (L < 128) { u.ty = 2; return ost.decode(L, u); }
                if (L < 128 + 384) { u.ty = 0; return oq.decode(L - 128, u); }
                u.ty = 1; return okv.decode(L - 512, u); } };
        Order2 S; S.G = G; S.c = bid; S.oq.init(MX / 256, 3, 1, G, 0); S.okv.init(MT / 256, 4, 1, G, 0); S.ost.init(NCH / 256, 1, 32, G, 0);
        LAS f32x2* tab = (LAS f32x2*)(lds + TAB_OFF);
        { Unit u; const int r_ = tid & 255; for (int ui = tid >> 8; S.next(ui, u); ui += 2) if (u.ty != 2) {
              const float* pp = P_PART + (size_t)(u.pm * 256 + r_) * 20;
              tab[ui * 256 + r_] = (f32x2){u.ty == 0 ? rstd_from(pp, 3, 1.0f / 384.0f) * QSCALE : rstd_from(pp + 12, 2, 1.0f / 256.0f), 0.f}; } }
        __syncthreads();
        pg8::Gemm3 g3;
        g3.A[0] = P_CQ; g3.A[1] = P_CQ + 384; g3.A[2] = P_UP; g3.Bt[0] = P_Wuq; g3.Bt[1] = P_Wukv; g3.Bt[2] = P_Bst;
        g3.nt[0] = 6; g3.nt[1] = 4; g3.nt[2] = 8; g3.gsA[0] = 0; g3.gsA[1] = 0; g3.gsA[2] = (size_t)NCH * 768; g3.gsB[0] = 0; g3.gsB[1] = 0; g3.gsB[2] = (size_t)256 * 512;
        g3.lda = 768; g3.ldb = 512;
        EpiQ E0{P_Q, tab, P_TAB}; EpiKV E1{P_KN, P_VV, tab}; EpiState E2{P_Sst};
        pg8::gemm_phase_multi<Order2, EpiQ, EpiKV, EpiState, true>(lds, g3, S, E0, E1, E2, wave);
    }
    XBAR();
    STAMP(3);
    const bool xl_use = (G == 256) && (__builtin_amdgcn_readfirstlane((int)xb_ld((unsigned*)(ws + WS_BAR) + XL_FLAG)) == 0);
#define XLBAR(k) do { if (xl_use) xl_barrier((unsigned*)(ws + WS_BAR), (unsigned*)(ws + WS_BAR) + XL_CNT(bid & 7, k), 32u); else XBAR(); } while (0)

    {
        LAS float* sl = (LAS float*)lds;
        ARGS_FRESH(); TID_FRESH();
        for (int idx = bid; idx < NB * 2 * 32; idx += G) {
            const int jx_ = idx >> 3, g = (G == 256) ? 4 * (idx & 7) + (jx_ & 3) : (idx & 31), dir = (G == 256) ? ((jx_ >> 2) & 1) : ((idx >> 5) & 1), b = (G == 256) ? (jx_ >> 3) : (idx >> 6), p = lane;
            const SsmP sp = ssm_params(ap->A_re, ap->A_im, ap->log_dt, dir, g, p);
            float aTr, aTi; lam_pow(sp.lr, sp.li, sp.dt, 32.f, aTr, aTi);
            float aSr, aSi; lam_pow(sp.lr, sp.li, sp.dt, 1024.f, aSr, aSi);
            float mr0 = 0.f, mi0 = 0.f;
            if (dir == 0) {
                const float* Br = ap->B_re + ((size_t)(g) * 64 + p) * 16; const float* Bi = ap->B_im + ((size_t)(g) * 64 + p) * 16;
                float brv[16], biv[16];
#pragma unroll
                for (int hh = 0; hh < 16; ++hh) { brv[hh] = Br[hh]; biv[hh] = Bi[hh]; }
#pragma unroll 4
                for (int j = 0; j < NMETA; ++j) {
                    float ur = 0.f, ui = 0.f;
#pragma unroll
                    for (int hh = 0; hh < 16; ++hh) { const float uu = P_UM[j * 512 + g * 16 + hh]; ur += brv[hh] * uu; ui += biv[hh] * uu; }
                    const float br = sp.qr * ur - sp.qi * ui, bi = sp.qr * ui + sp.qi * ur;
                    float pr, pi; lam_pow(sp.lr, sp.li, sp.dt, (float)(NMETA - 1 - j), pr, pi);
                    mr0 += pr * br - pi * bi; mi0 += pr * bi + pi * br;
                }
            }
            const int c0 = b * 256 + wave * 32;
            float sre[32], sim[32];
#pragma unroll
            for (int k = 0; k < 32; ++k) { const float* s = P_Sst + ((size_t)g * NCH + c0 + k) * 256 + dir * 128 + p; sre[k] = s[0]; sim[k] = s[64]; }
            float xr = 0.f, xi = 0.f;
            if (dir == 0) {
#pragma unroll
                for (int k = 0; k < 32; ++k) { const float nr = aTr * xr - aTi * xi + sre[k], ni = aTr * xi + aTi * xr + sim[k]; xr = nr; xi = ni; }
            } else {
#pragma unroll
                for (int k = 31; k >= 0; --k) { const float nr = aTr * xr - aTi * xi + sre[k], ni = aTr * xi + aTi * xr + sim[k]; xr = nr; xi = ni; }
            }
            sl[(wave * 64 + p) * 2] = xr; sl[(wave * 64 + p) * 2 + 1] = xi;
            __syncthreads();
            float cr = 0.f, ci = 0.f;
            if (dir == 0) {
                cr = mr0; ci = mi0;
                for (int w = 0; w < wave; ++w) { const float tr = sl[(w * 64 + p) * 2], ti = sl[(w * 64 + p) * 2 + 1];
                    const float nr = aSr * cr - aSi * ci + tr, ni = aSr * ci + aSi * cr + ti; cr = nr; ci = ni; }
                xr = cr; xi = ci;
#pragma unroll
                for (int k = 0; k < 32; ++k) {
                    bf16_t* d = P_UP + ((size_t)g * NCH + c0 + k) * 768 + 512 + p; d[0] = f2bf(xr); d[64] = f2bf(xi);
                    const float nr = aTr * xr - aTi * xi + sre[k], ni = aTr * xi + aTi * xr + sim[k]; xr = nr; xi = ni; }
            } else {
                for (int w = NWAVES - 1; w > wave; --w) { const float tr = sl[(w * 64 + p) * 2], ti = sl[(w * 64 + p) * 2 + 1];
                    const float nr = aSr * cr - aSi * ci + tr, ni = aSr * ci + aSi * cr + ti; cr = nr; ci = ni; }
                xr = cr; xi = ci;
#pragma unroll
                for (int k = 31; k >= 0; --k) {
                    bf16_t* d = P_UP + ((size_t)g * NCH + c0 + k) * 768 + 512 + 128 + p; d[0] = f2bf(xr); d[64] = f2bf(xi);
                    const float nr = aTr * xr - aTi * xi + sre[k], ni = aTr * xi + aTi * xr + sim[k]; xr = nr; xi = ni; }
            }
            __syncthreads();
        }
        const int vcu = (G % 8 == 0) ? (bid % 8) * (G / 8) + bid / 8 : bid;
        for (int L = vcu; L < NB * 8 * 32; L += G) {
            const int bh = L >> 5, qb = L & 31;
            if (!attn::attn_unit<false>(bh >> 3, bh & 7, qb, P_Q, P_KN, P_KR, P_VV, P_MIX, P_PARTA, (char*)lds_raw, (const LAS char*)lds, wave))
                (void)attn::attn_unit<true>(bh >> 3, bh & 7, qb, P_Q, P_KN, P_KR, P_VV, P_MIX, P_PARTA, (char*)lds_raw, (const LAS char*)lds, wave);
        }
    }
    XLBAR(3);
    STAMP(4);

    { pg8::Gemm g{P_UP, P_Mout, 768, 768, 768, (size_t)NCH * 768, (size_t)512 * 768}; pg8::Order S; S.init(NCH / 256, 2, 32, G, bid);
      EpiY E{P_Y}; pg8::gemm_phase<EpiY, true>(lds, g, S, E, wave); }
    XBAR();
    STAMP(5);
    { pg8::Gemm g{P_Y, P_Wglu, 512, 512, 512, 0, 0}; pg8::Order S; S.init(MX / 256, 4, 1, G, bid);
      EpiGLU E{P_MIX, P_PARTS}; pg8::gemm_phase<EpiGLU, true>(lds, g, S, E, wave); }
    XLBAR(0);
    STAMP(6);
    { ARGS_FRESH(); TID_FRESH();
      pg8::Gemm g{P_MIX, P_Wout, 1024, 1024, 1024, 0, 0}; pg8::Order S; S.init(MX / 256, 4, 1, G, bid);
      LAS f32x2* tab = (LAS f32x2*)(lds + TAB_OFF);
      { Unit u; const int r_ = tid & 255; for (int ui = tid >> 8; S.next(ui, u); ui += 2) { const int row = u.pm * 256 + r_;
            const float ra = rstd_from(P_PARTA + (size_t)row * 8, 2, 1.0f / 512.0f), rs = rstd_from(P_PARTS + (size_t)row * 16, 4, 1.0f / 512.0f);
            tab[ui * 256 + r_] = (f32x2){ra / rs, rs}; } }
      __syncthreads();
      unsigned* cntb = (unsigned*)(ws + WS_CNT); float* xb = (float*)(ws + WS_XB);
      PanelRms st1{xb, cntb, (unsigned*)(ws + WS_BAR) + XB_TMO};
      EpiWoutLN E{P_XN, P_XN2, P_TAB, ap->g_post_mix, tab, lds + TAB_OFF + 4096, st1};
      pg8::gemm_phase<EpiWoutLN, true>(lds, g, S, E, wave); }
    if (xl_use) {
        unsigned* bw_ = (unsigned*)(ws + WS_BAR);
        xl_barrier(bw_, bw_ + XL_CNT(bid & 7, 1), 32u);
        if (threadIdx.x == 0) {
            if ((bid >> 3) == 0) (void)xb_add(bw_ + XL_P6DONE, 1u);
            if ((bid & 7) < 2) XB_SPIN(xb_ld(bw_ + XL_P6DONE) < 8u, bw_);
        }
        if ((bid & 7) < 2) __syncthreads();
    } else XBAR();
    STAMP(7);
    STAMP(8);
    { TID_FRESH();
      pg8::Gemm g{P_XN2, P_Wup, 1024, 1024, 1024, 0, 0}; pg8::Order S; S.init(MX / 256, 16, 1, G, bid); S.rev = 1;
      LAS float* tabf = (LAS float*)(lds + TAB_OFF);
      { Unit u; for (int ui = wave; S.next(ui, u); ui += NWAVES) {
            f32x4 v[4][8];
#pragma unroll
            for (int r = 0; r < 4; ++r) { const float* pp = P_TAB + (size_t)(u.pm * 256 + lane + 64 * r) * 32;
#pragma unroll
                for (int i = 0; i < 8; ++i) v[r][i] = *(const f32x4*)(pp + 4 * i); }
#pragma unroll
            for (int r = 0; r < 4; ++r) { float ssq = 0.f;
#pragma unroll
                for (int i = 0; i < 8; ++i) ssq += (v[r][i][0] + v[r][i][1]) + (v[r][i][2] + v[r][i][3]);
                tabf[ui * 256 + lane + 64 * r] = __builtin_amdgcn_rcpf(ssq * (1.0f / 1024.0f) + EPS); } } }
      __syncthreads();
      EpiRelu2 E{P_H, tabf}; pg8::gemm_phase<EpiRelu2, true>(lds, g, S, E, wave); }
    XLBAR(2);
    STAMP(9);
    { ARGS_FRESH();
      pg8::Gemm g{P_H, P_Wdn, 4096, 4096, 4096, 0, 0}; pg8::Order S; S.init(MX / 256, 4, 1, G, bid);
      PanelRms st{(float*)(ws + WS_XB) + 2 * 131072, (unsigned*)(ws + WS_CNT) + 2 * 128 * 64, (unsigned*)(ws + WS_BAR) + XB_TMO};
      EpiDownLN E{ap->out, P_XN2, ap->g_post_mlp, lds + TAB_OFF + 4096, st};
      pg8::gemm_phase<EpiDownLN, true>(lds, g, S, E, wave); }
    STAMP(10);
    if (PROBE_A >= 0 && blockIdx.x == 0 && tid_of(wave) == 0) {
        asm volatile("s_waitcnt vmcnt(0)" ::: "memory");
        const unsigned long long t1 = PROBE_B >= 11 ? __builtin_amdgcn_s_memrealtime() : ((volatile unsigned long long*)ws)[PROBE_B < 11 ? PROBE_B : 0];
        const unsigned long long t0 = ((volatile unsigned long long*)ws)[PROBE_A >= 0 ? PROBE_A : 0];
        ap0->out[0] = (float)(long long)(t1 - t0) * 0.01f;
    }
}

extern "C" void kernel_launch(void* const* d_in, const int* in_sizes, int n_in, void* d_out, int out_size, void* d_ws, size_t ws_size, hipStream_t stream) {
    static int grid = 0;
    if (grid == 0) {
        if (n_in != 25 || out_size != MX * DM || ws_size < WS_END) { fprintf(stderr, "kernel_launch: unexpected shapes n_in %d out %d ws %zu\n", n_in, out_size, ws_size); grid = -1; return; }
        int dev = 0, cus = 0, per_cu = 0;
        (void)hipGetDevice(&dev);
        (void)hipDeviceGetAttribute(&cus, hipDeviceAttributeMultiprocessorCount, dev);
        (void)hipFuncSetAttribute((const void*)fwd_megakernel, hipFuncAttributeMaxDynamicSharedMemorySize, LDS_BYTES);
        (void)hipOccupancyMaxActiveBlocksPerMultiprocessor(&per_cu, (const void*)fwd_megakernel, NTHR, LDS_BYTES);
        if (per_cu < 1) { fprintf(stderr, "kernel_launch: occupancy query says %d\n", per_cu); grid = -1; return; }
        grid = cus * 1;
        fprintf(stderr, "kernel_launch: cus %d per_cu %d grid %d ws %zu\n", cus, per_cu, grid, ws_size);
    }
    if (grid < 0) return;
    Args a{};
    const float** fp = (const float**)&a;
    a.x = (const float*)d_in[0]; a.positions = (const int*)d_in[1]; a.meta = (const float*)d_in[2];
    a.g_pre_mix = (const float*)d_in[3]; a.w_in = (const float*)d_in[4]; a.g_q_lat = (const float*)d_in[5]; a.w_uq = (const float*)d_in[6]; a.g_kv_lat = (const float*)d_in[7]; a.w_ukv = (const float*)d_in[8];
    a.A_re = (const float*)d_in[9]; a.A_im = (const float*)d_in[10]; a.log_dt = (const float*)d_in[11]; a.B_re = (const float*)d_in[12]; a.B_im = (const float*)d_in[13]; a.C_re = (const float*)d_in[14]; a.C_im = (const float*)d_in[15];
    a.Dv = (const float*)d_in[16]; a.w_glu = (const float*)d_in[17]; a.g_mix_out = (const float*)d_in[18]; a.w_out = (const float*)d_in[19]; a.g_post_mix = (const float*)d_in[20]; a.g_pre_mlp = (const float*)d_in[21];
    a.w_up = (const float*)d_in[22]; a.w_down = (const float*)d_in[23]; a.g_post_mlp = (const float*)d_in[24];
    (void)fp;
    a.out = (float*)d_out; a.ws = (unsigned char*)d_ws;
    (void)hipMemsetAsync((char*)d_ws + WS_BAR, 0, (WS_CNT - WS_BAR) + 3 * 128 * 64 * 4, stream);
    void* args[] = {&a};
    hipError_t e = hipLaunchCooperativeKernel((const void*)fwd_megakernel, dim3(grid), dim3(NTHR), args, LDS_BYTES, stream);
    if (e != hipSuccess) fprintf(stderr, "cooperative launch failed: %s (grid %d)\n", hipGetErrorString(e), grid);
}
```
